# Optimizing an MI355X kernel written in HIP

```python
import math
import jax, jax.numpy as jnp
from jax import lax
import numpy as np

D_MODEL = 2048
BATCH = 4
SEQ = 4096
DEPTH = 2
DEC_BATCH = 16
DEC_SEQ = 32
PAST_LEN = 1024

CHUNK = 64
HEAD_DIM = 128
D_TOK = 3 * D_MODEL // 4
D_MEM = D_MODEL // 4
SB_HEADS = D_TOK // HEAD_DIM
MEM_HEADS = D_MEM // HEAD_DIM
N_MEM = 256
POOL_WINDOWS = (2, 4, 8, 16)
POOL_GROUP = D_TOK // len(POOL_WINDOWS)
POOL_STATE = max(POOL_WINDOWS) - 1
D_FF = 4 * D_MODEL
N_POOL_LAYERS = (DEPTH + 1) // 2
N_SB_LAYERS = DEPTH // 2
Q_BLOCK = 128
EPS = 1e-6

kernel_name = 'hybrid_pool_stickbreak_stream_step'


def rmsnorm(x, g):
    xf = x.astype(jnp.float32)
    y = xf * lax.rsqrt(jnp.mean(xf * xf, axis=-1, keepdims=True) + EPS) * g.astype(jnp.float32)
    return y.astype(x.dtype)


def pool_mix(u, prev, past_len, w_grp, scale):
    B, T, C = u.shape
    P = POOL_STATE
    ext = jnp.concatenate([prev.astype(u.dtype), u], axis=1).astype(jnp.float32)
    cs = jnp.concatenate([jnp.zeros((B, 1, C), jnp.float32), jnp.cumsum(ext, axis=1)], axis=1)
    pos = (past_len + jnp.arange(T)).astype(jnp.float32)
    cur = ext[:, P:]
    outs = []
    for g, w in enumerate(POOL_WINDOWS):
        sl = slice(g * POOL_GROUP, (g + 1) * POOL_GROUP)
        win = cs[:, P + 1:P + 1 + T, sl] - cs[:, P + 1 - w:P + 1 - w + T, sl]
        cnt = jnp.minimum(pos + 1.0, float(w))
        d = (win / cnt[None, :, None] - cur[..., sl]).astype(u.dtype)
        outs.append(jnp.einsum('btc,cd->btd', d, w_grp[g]))
    out = jnp.concatenate(outs, axis=-1) * scale
    new_prev = ext[:, -P:].astype(u.dtype)
    return out, new_prev


def sb_attention(q, k, v, past_len):
    B, T, H, Dh = q.shape
    S = k.shape[1]
    kpos = jnp.arange(S)
    qpos = past_len + jnp.arange(T)
    inv = 1.0 / math.sqrt(Dh)

    def block(qb, qp):
        z = jnp.einsum('bqhd,bshd->bhqs', qb, k).astype(jnp.float32) * inv
        mask = (kpos[None, :] < qp[:, None])[None, None]
        log_fail = jnp.where(mask, jax.nn.log_sigmoid(-z), 0.0)
        after = lax.cumsum(log_fail, axis=3, reverse=True) - log_fail
        a = jnp.where(mask, jnp.exp(jax.nn.log_sigmoid(z) + after), 0.0)
        return jnp.einsum('bhqs,bshd->bqhd', a.astype(v.dtype), v)

    if T % Q_BLOCK == 0 and T > Q_BLOCK:
        nb = T // Q_BLOCK
        qs = q.reshape(B, nb, Q_BLOCK, H, Dh).transpose(1, 0, 2, 3, 4)
        ps = qpos.reshape(nb, Q_BLOCK)
        out = lax.map(lambda a: block(a[0], a[1]), (qs, ps))
        return out.transpose(1, 0, 2, 3, 4).reshape(B, T, H, Dh)
    return block(q, qpos)


def head_rmsnorm(x, g):
    return rmsnorm(x, g)


def mem_kv(mem, g_mem, w_kv, k_gain):
    B, N, _ = mem.shape
    kv = rmsnorm(mem, g_mem) @ w_kv
    k = head_rmsnorm(kv[..., :D_MEM].reshape(B, N, MEM_HEADS, HEAD_DIM), k_gain)
    v = kv[..., D_MEM:].reshape(B, N, MEM_HEADS, HEAD_DIM)
    return k, v


def mem_attention(q, mk, mv):
    s = jnp.einsum('bthd,bmhd->bhtm', q, mk).astype(jnp.float32) / math.sqrt(HEAD_DIM)
    p = jax.nn.softmax(s, axis=-1)
    return jnp.einsum('bhtm,bmhd->bthd', p.astype(mv.dtype), mv)


def run_trunk(x, past_len, pool_prev, sb_past_k, sb_past_v, mem_k, mem_v,
              norm_mix, w_in_pool, w_in_sb, pool_w, pool_scale, q_norm,
              w_out, norm_ffn, w_up, w_down):
    B, T, _ = x.shape
    pool_new, sbk_new, sbv_new = [], [], []
    for i in range(DEPTH):
        j = i // 2
        h = rmsnorm(x, norm_mix[i])
        if i % 2 == 0:
            proj = h @ w_in_pool[j]
            mix, new_prev = pool_mix(proj[..., :D_TOK], pool_prev[j], past_len, pool_w[j], pool_scale[j])
            pool_new.append(new_prev)
            qm = proj[..., D_TOK:]
        else:
            proj = h @ w_in_sb[j]
            q = proj[..., :D_TOK].reshape(B, T, SB_HEADS, HEAD_DIM)
            k = proj[..., D_TOK:2 * D_TOK].reshape(B, T, SB_HEADS, HEAD_DIM)
            v = proj[..., 2 * D_TOK:3 * D_TOK].reshape(B, T, SB_HEADS, HEAD_DIM)
            kk = jnp.concatenate([sb_past_k[j].astype(k.dtype), k], axis=1)
            vv = jnp.concatenate([sb_past_v[j].astype(v.dtype), v], axis=1)
            mix = sb_attention(q, kk, vv, past_len).reshape(B, T, D_TOK)
            sbk_new.append(k)
            sbv_new.append(v)
            qm = proj[..., 3 * D_TOK:]
        qm = head_rmsnorm(qm.reshape(B, T, MEM_HEADS, HEAD_DIM), q_norm[i])
        mo = mem_attention(qm, mem_k[i].astype(qm.dtype), mem_v[i].astype(qm.dtype)).reshape(B, T, D_MEM)
        x = x + jnp.concatenate([mix, mo], axis=-1) @ w_out[i]
        h2 = rmsnorm(x, norm_ffn[i])
        x = x + jnp.square(jax.nn.relu(h2 @ w_up[i])) @ w_down[i]
    return x, jnp.stack(pool_new), jnp.stack(sbk_new), jnp.stack(sbv_new)


def setup_inputs(seed: int = 0) -> dict:
    key = jax.random.key(seed)
    ks = jax.random.split(key, 24)
    f32 = jnp.float32
    nrm = lambda k, s, sc=1.0: jax.random.normal(k, s, f32) * sc
    gain = lambda k, s: 1.0 + 0.05 * jax.random.normal(k, s, f32)
    return {
        'x_prompt': nrm(ks[0], (BATCH, SEQ, D_MODEL)),
        'x_sample': nrm(ks[1], (DEC_BATCH, DEC_SEQ, D_MODEL)),
        'mem_prompt': nrm(ks[2], (BATCH, N_MEM, D_MODEL)),
        'cache_pool': nrm(ks[3], (N_POOL_LAYERS, DEC_BATCH, POOL_STATE, D_TOK)),
        'cache_sb_k': nrm(ks[4], (N_SB_LAYERS, DEC_BATCH, PAST_LEN, SB_HEADS, HEAD_DIM)),
        'cache_sb_v': nrm(ks[5], (N_SB_LAYERS, DEC_BATCH, PAST_LEN, SB_HEADS, HEAD_DIM)),
        'cache_mem_k': nrm(ks[6], (DEPTH, DEC_BATCH, N_MEM, MEM_HEADS, HEAD_DIM)),
        'cache_mem_v': nrm(ks[7], (DEPTH, DEC_BATCH, N_MEM, MEM_HEADS, HEAD_DIM)),
        'norm_mix': gain(ks[8], (DEPTH, D_MODEL)),
        'w_in_pool': nrm(ks[9], (N_POOL_LAYERS, D_MODEL, D_TOK + D_MEM), D_MODEL ** -0.5),
        'w_in_sb': nrm(ks[10], (N_SB_LAYERS, D_MODEL, 3 * D_TOK + D_MEM), D_MODEL ** -0.5),
        'pool_w': nrm(ks[11], (N_POOL_LAYERS, len(POOL_WINDOWS), POOL_GROUP, POOL_GROUP), POOL_GROUP ** -0.5),
        'pool_scale': 1.0 + 0.1 * jax.random.normal(ks[12], (N_POOL_LAYERS, D_TOK), f32),
        'norm_mem': gain(ks[13], (DEPTH, D_MODEL)),
        'w_mem_kv': nrm(ks[14], (DEPTH, D_MODEL, 2 * D_MEM), D_MODEL ** -0.5),
        'q_norm': gain(ks[15], (DEPTH, HEAD_DIM)),
        'k_norm': gain(ks[16], (DEPTH, HEAD_DIM)),
        'w_out': nrm(ks[17], (DEPTH, D_TOK + D_MEM, D_MODEL), (D_TOK + D_MEM) ** -0.5),
        'norm_ffn': gain(ks[18], (DEPTH, D_MODEL)),
        'w_up': nrm(ks[19], (DEPTH, D_MODEL, D_FF), D_MODEL ** -0.5),
        'w_down': nrm(ks[20], (DEPTH, D_FF, D_MODEL), D_FF ** -0.5),
    }


def reference(x_prompt, x_sample, mem_prompt, cache_pool, cache_sb_k, cache_sb_v,
              cache_mem_k, cache_mem_v, norm_mix, w_in_pool, w_in_sb, pool_w, pool_scale,
              norm_mem, w_mem_kv, q_norm, k_norm, w_out, norm_ffn, w_up, w_down):
    mks, mvs = [], []
    for i in range(DEPTH):
        mk, mv = mem_kv(mem_prompt, norm_mem[i], w_mem_kv[i], k_norm[i])
        mks.append(mk)
        mvs.append(mv)
    mem_k_prompt = jnp.stack(mks)
    mem_v_prompt = jnp.stack(mvs)
    B = x_prompt.shape[0]
    pool_zero = jnp.zeros((N_POOL_LAYERS, B, POOL_STATE, D_TOK), x_prompt.dtype)
    sb_empty = jnp.zeros((N_SB_LAYERS, B, 0, SB_HEADS, HEAD_DIM), x_prompt.dtype)
    y_prompt, pool_prompt, sb_k_prompt, sb_v_prompt = run_trunk(
        x_prompt, 0, pool_zero, sb_empty, sb_empty, mem_k_prompt, mem_v_prompt,
        norm_mix, w_in_pool, w_in_sb, pool_w, pool_scale, q_norm,
        w_out, norm_ffn, w_up, w_down)
    past = cache_sb_k.shape[2]
    y_sample, pool_sample, sb_k_sample, sb_v_sample = run_trunk(
        x_sample, past, cache_pool, cache_sb_k, cache_sb_v, cache_mem_k, cache_mem_v,
        norm_mix, w_in_pool, w_in_sb, pool_w, pool_scale, q_norm,
        w_out, norm_ffn, w_up, w_down)
    return (y_prompt, y_sample, pool_prompt, pool_sample, sb_k_prompt, sb_v_prompt,
            sb_k_sample, sb_v_sample, mem_k_prompt, mem_v_prompt)
```

```cpp
#include <hip/hip_runtime.h>
#include <hip/hip_cooperative_groups.h>
#include <cstdio>
namespace cg = cooperative_groups;

#define LAS __attribute__((address_space(3)))
#define DI __device__ __forceinline__
typedef unsigned short bf16_t;
typedef short bf16x8 __attribute__((ext_vector_type(8)));
typedef short s16x4 __attribute__((ext_vector_type(4)));
typedef float f32x4 __attribute__((ext_vector_type(4)));
typedef float f32x16 __attribute__((ext_vector_type(16)));
typedef unsigned u32x4 __attribute__((ext_vector_type(4)));
typedef unsigned u32x2 __attribute__((ext_vector_type(2)));

constexpr int DM = 2048, MP = 16384, MS = 512, MT = 16896, NMT = 1024, DTOK = 1536, DMEM = 512, DFF = 8192;
constexpr int SEQ = 4096, DSEQ = 32, PAST = 1024, NSBH = 12, HD = 128;
constexpr float EPS = 1e-6f;
constexpr size_t O_Y = 0, O_PP = 34603008, O_PS = O_PP + 92160, O_SKP = O_PS + 368640, O_SVP = O_SKP + 25165824,
                 O_SKS = O_SVP + 25165824, O_SVS = O_SKS + 786432, O_MK = O_SVS + 786432, O_MV = O_MK + 1048576;
constexpr size_t WS_WINP = 0;
constexpr size_t WS_WINS = WS_WINP + (size_t)2048 * 2048 * 2;
constexpr size_t WS_POOLW = WS_WINS + (size_t)5120 * 2048 * 2;
constexpr size_t WS_WKV = WS_POOLW + (size_t)4 * 512 * 384 * 2;
constexpr size_t WS_WOUT = WS_WKV + (size_t)2 * 1024 * 2048 * 2;
constexpr size_t WS_WUP = WS_WOUT + (size_t)2 * 2048 * 2048 * 2;
constexpr size_t WS_WDOWN = WS_WUP + (size_t)2 * 8192 * 2048 * 2;
constexpr size_t WS_XB = WS_WDOWN + (size_t)2 * 2048 * 8192 * 2;
constexpr size_t WS_MB = WS_XB + (size_t)MT * 2048 * 2;
constexpr size_t WS_SSP = WS_MB + (size_t)NMT * 2048 * 2;
constexpr size_t WS_SSPM = WS_SSP + (size_t)MT * 32 * 4;
constexpr size_t WS_KV = WS_SSPM + (size_t)NMT * 32 * 4;
constexpr size_t WS_MK = WS_KV + (size_t)2 * 1024 * 1024 * 4;
constexpr size_t WS_MV = WS_MK + (size_t)2 * 20 * 256 * 512 * 2;
constexpr size_t WS_BIG = WS_MV + (size_t)2 * 20 * 256 * 512 * 2;
constexpr size_t WS_END = WS_BIG + (size_t)MT * 8192 * 2;
constexpr size_t BG_U = 0, BG_D = (size_t)MT * 1536 * 4, BG_QM = BG_D + (size_t)MT * 1536 * 2, BG_CAT = BG_QM + (size_t)MT * 512 * 2;
constexpr size_t BG_Q = 0, BG_K = (size_t)MT * 1536 * 2, BG_V = 2 * BG_K;

constexpr int LDS_BYTES = 151552;

struct Params {
    const float* in[21];
    float* out;
    unsigned char* ws;
};
enum { I_XP = 0, I_XS, I_MEM, I_CPOOL, I_CSBK, I_CSBV, I_CMK, I_CMV, I_NMIX, I_WINP, I_WINS, I_POOLW, I_PSCALE, I_NMEM, I_WKV, I_QN, I_KN, I_WOUT, I_NFFN, I_WUP, I_WDOWN };

DI unsigned cvt_pk_bf16(float lo, float hi) { unsigned r; asm("v_cvt_pk_bf16_f32 %0, %1, %2" : "=v"(r) : "v"(lo), "v"(hi)); return r; }
DI int otid() { int t = threadIdx.x; asm volatile("" : "+v"(t)); return t; }
DI float bf_lo(unsigned u) { return __uint_as_float(u << 16); }
DI float bf_hi(unsigned u) { return __uint_as_float(u & 0xffff0000u); }

constexpr int BM = 256, BK = 64, HALF = 128, HTB = HALF * BK * 2, NXCD = 8, WGM = 8;
__host__ __device__ __forceinline__ int lds_byte(int r, int c) { const int st = (r >> 4) * 2 + (c >> 5), rr = r & 15, cc = c & 31, ob = rr * 64 + cc * 2; return st * 1024 + (ob ^ (((ob >> 9) & 1) << 5)); }
__host__ __device__ __forceinline__ void stage_rc(int b, int& R, int& C) { const int st = b / 1024, sb = b % 1024, swz = sb ^ (((sb >> 9) & 1) << 5); R = (st >> 1) * 16 + swz / 64; C = (st & 1) * 32 + (swz % 64) / 2; }
__host__ __device__ __forceinline__ int perm32(int rho) { const int n = rho >> 4, i = rho & 15; return 8 * (i >> 2) + 4 * n + (i & 3); }

struct Unit { int pm, pn; };
enum { MODE_INPOOL = 0, MODE_KV, MODE_POOL, MODE_RESID, MODE_UP, MODE_INSB };
struct GemmJob {
    const bf16_t* A; const bf16_t* Bt;
    int lda, ldb, K, nM, nN, mode, layer, coff, last;
};

DI bool unit_next(const GemmJob& g, int i, Unit& u) {
    const int G = gridDim.x; const int c = ((int)blockIdx.x - g.coff + G) % G;
    const int nwg = g.nM * g.nN; const long L = (long)i * G + c; if (L >= nwg) return false;
    int wgid = (int)L; { const int q = nwg / NXCD, r = nwg % NXCD, xcd = wgid % NXCD, off = wgid / NXCD; wgid = (xcd < r ? xcd * (q + 1) : r * (q + 1) + (xcd - r) * q) + off; }
    const int nig = WGM * g.nN, gid = wgid / nig, fm = gid * WGM, gsz = (g.nM - fm) < WGM ? (g.nM - fm) : WGM;
    u.pm = fm + ((wgid % nig) % gsz); u.pn = (wgid % nig) / gsz; return true;
}
DI const char* unit_a(const GemmJob& g, const Unit& u) {
    const char* p = (const char*)g.A + (size_t)u.pm * 256 * g.lda * 2;
    if (g.mode == MODE_POOL) p += (size_t)(u.pn >> 1) * 384 * 2;
    return p;
}
DI const char* unit_b(const GemmJob& g, const Unit& u) { return (const char*)g.Bt + (size_t)u.pn * 256 * g.ldb * 2; }

DI float row_rstd(const float* ssp, int row, int fq) {
    const f32x4 a = *(const f32x4*)(ssp + (size_t)row * 32 + fq * 8), b = *(const f32x4*)(ssp + (size_t)row * 32 + fq * 8 + 4);
    float s = (a[0] + a[1]) + (a[2] + a[3]) + (b[0] + b[1]) + (b[2] + b[3]);
    s += __shfl_xor(s, 16); s += __shfl_xor(s, 32);
    return rsqrtf(s * (1.0f / 2048.0f) + EPS);
}

DI void epilogue(const f32x4 (&acc)[2][2][4][2], const GemmJob& g, const Params& P, const Unit& u, int wr, int wc, int fr, int fq) {
    unsigned char* ws = P.ws;
    const float* ssp = nullptr; const float* resid = nullptr; int resid_row0 = 0;
    float* of32 = nullptr; int ldf = 0, colf = 0, f32_row0 = 0;
    bf16_t* obf = nullptr; int ldo = 0, colb = 0; int climit = 256; bool act = false; float* ssp_out = nullptr;
    const int pm = u.pm, pn = u.pn;
    switch (g.mode) {
    case MODE_INPOOL:
        ssp = (const float*)(ws + WS_SSP);
        if (pn < 6) { of32 = (float*)(ws + WS_BIG + BG_U); ldf = 1536; colf = pn * 256; }
        else { obf = (bf16_t*)(ws + WS_BIG + BG_QM); ldo = 512; colb = (pn - 6) * 256; }
        break;
    case MODE_KV:
        ssp = (const float*)(ws + WS_SSPM);
        of32 = (float*)(ws + WS_KV) + (size_t)g.layer * 1024 * 1024; ldf = 1024; colf = pn * 256;
        break;
    case MODE_POOL:
        obf = (bf16_t*)(ws + WS_BIG + BG_CAT); ldo = 2048; colb = (pn >> 1) * 384 + (pn & 1) * 256; climit = (pn & 1) ? 128 : 256;
        break;
    case MODE_RESID:
        if (g.layer == 0) { if (pm < 64) { resid = P.in[I_XP]; resid_row0 = 0; } else { resid = P.in[I_XS]; resid_row0 = MP; } }
        else { resid = P.out + O_Y; resid_row0 = 0; }
        of32 = P.out + O_Y; ldf = 2048; colf = pn * 256;
        if (!g.last) { obf = (bf16_t*)(ws + WS_XB); ldo = 2048; colb = pn * 256; ssp_out = (float*)(ws + WS_SSP); }
        break;
    case MODE_UP:
        ssp = (const float*)(ws + WS_SSP); act = true;
        obf = (bf16_t*)(ws + WS_BIG); ldo = 8192; colb = pn * 256;
        break;
    default:
        ssp = (const float*)(ws + WS_SSP);
        if (pn < 6) { obf = (bf16_t*)(ws + WS_BIG + BG_Q); ldo = 1536; colb = pn * 256; }
        else if (pn < 12) { obf = (bf16_t*)(ws + WS_BIG + BG_K); ldo = 1536; colb = (pn - 6) * 256;
            of32 = P.out + (pm < 64 ? O_SKP : O_SKS); f32_row0 = pm < 64 ? 0 : MP; ldf = 1536; colf = colb; }
        else if (pn < 18) { obf = (bf16_t*)(ws + WS_BIG + BG_V); ldo = 1536; colb = (pn - 12) * 256;
            of32 = P.out + (pm < 64 ? O_SVP : O_SVS); f32_row0 = pm < 64 ? 0 : MP; ldf = 1536; colf = colb; }
        else { obf = (bf16_t*)(ws + WS_BIG + BG_QM); ldo = 512; colb = (pn - 18) * 256; }
        break;
    }
    const int row0 = pm * 256 + wr * 64 + fr; const int cl0 = wc * 32 + fq * 8;
#pragma unroll
    for (int ai = 0; ai < 2; ++ai)
#pragma unroll
        for (int m = 0; m < 4; ++m) {
            const int r = row0 + ai * HALF + m * 16;
            float rs = 1.0f;
            if (ssp) rs = row_rstd(ssp, r, fq);
            float ssq = 0.f;
#pragma unroll
            for (int bj = 0; bj < 2; ++bj) {
                const int cl = cl0 + bj * HALF;
                if (cl < climit) {
                    f32x4 v0 = acc[ai][bj][m][0] * rs, v1 = acc[ai][bj][m][1] * rs;
                    if (resid) { const float* rp = resid + (size_t)(r - resid_row0) * 2048 + pn * 256 + cl; v0 += *(const f32x4*)rp; v1 += *(const f32x4*)(rp + 4); }
                    if (act) {
#pragma unroll
                        for (int j = 0; j < 4; ++j) { const float a0 = fmaxf(v0[j], 0.f), a1 = fmaxf(v1[j], 0.f); v0[j] = a0 * a0; v1[j] = a1 * a1; }
                    }
                    if (of32) { float* op = of32 + (size_t)(r - f32_row0) * ldf + colf + cl; *(f32x4*)op = v0; *(f32x4*)(op + 4) = v1; }
                    if (obf) { u32x4 w; w.x = cvt_pk_bf16(v0[0], v0[1]); w.y = cvt_pk_bf16(v0[2], v0[3]); w.z = cvt_pk_bf16(v1[0], v1[1]); w.w = cvt_pk_bf16(v1[2], v1[3]);
                        *(u32x4*)(obf + (size_t)r * ldo + colb + cl) = w; }
                    ssq += (v0[0] * v0[0] + v0[1] * v0[1]) + (v0[2] * v0[2] + v0[3] * v0[3]) + (v1[0] * v1[0] + v1[1] * v1[1]) + (v1[2] * v1[2] + v1[3] * v1[3]);
                }
            }
            if (ssp_out) { ssq += __shfl_xor(ssq, 16); ssq += __shfl_xor(ssq, 32); if (fq == 0) ssp_out[(size_t)r * 32 + pn * 4 + wc] = ssq; }
        }
}

__device__ __forceinline__ void gemm_phase(LAS unsigned char* lds, const GemmJob& g, const Params& P) {
    const int tid = otid(), wid = __builtin_amdgcn_readfirstlane(tid >> 6), lane = tid & 63, wr = wid >> 2, wc = wid & 3, fr = lane & 15, fq = lane >> 4;
    const int K = g.K, nt = K / BK;
    unsigned voffA[2], voffB[2];
#pragma unroll
    for (int i = 0; i < 2; ++i) { int R, C; stage_rc(tid * 16 + i * 8192, R, C); const int Rb = (R & ~31) + perm32(R & 31);
        voffA[i] = (unsigned)(R * g.lda + C) * 2u; voffB[i] = (unsigned)(Rb * g.ldb + C) * 2u; }
    const size_t kstep = (size_t)(BK * 2);
    const size_t hstepA = (size_t)HALF * g.lda * 2, hstepB = (size_t)HALF * g.ldb * 2;
    const unsigned ldsw = (unsigned)wid * 1024u;
    const int aoff = lds_byte(wr * 64 + fr, fq * 8), boff = lds_byte(wc * 32 + fr, fq * 8);
#define PG8_SA(b, h) (((b) * 2 + (h)) * HTB)
#define PG8_SB(b, h) ((4 + (b) * 2 + (h)) * HTB)
#define PG8_STAGE(bufoff, gbase, voff) do { _Pragma("unroll") for (int _i = 0; _i < 2; ++_i) \
        __builtin_amdgcn_global_load_lds((const unsigned*)((const char*)(gbase) + (voff)[_i]), (LAS unsigned*)(lds + (bufoff) + ldsw + _i * 8192), 16, 0, 0); } while (0)
#define PG8_LDA(dst, b, h) do { _Pragma("unroll") for (int m = 0; m < 4; ++m) _Pragma("unroll") for (int k = 0; k < 2; ++k) dst[m][k] = *(const LAS bf16x8*)(lds + PG8_SA(b, h) + aoff + m * 2048 + k * 1024); } while (0)
#define PG8_LDB(dst, b, h) do { _Pragma("unroll") for (int n = 0; n < 2; ++n) _Pragma("unroll") for (int k = 0; k < 2; ++k) dst[n][k] = *(const LAS bf16x8*)(lds + PG8_SB(b, h) + boff + n * 2048 + k * 1024); } while (0)
#define PG8_MMA(ai, bj, At, Bt) do { __builtin_amdgcn_s_setprio(1); _Pragma("unroll") for (int m = 0; m < 4; ++m) _Pragma("unroll") for (int n = 0; n < 2; ++n) _Pragma("unroll") for (int k = 0; k < 2; ++k) \
        acc[ai][bj][m][n] = __builtin_amdgcn_mfma_f32_16x16x32_bf16(Bt[n][k], At[m][k], acc[ai][bj][m][n], 0, 0, 0); __builtin_amdgcn_s_setprio(0); } while (0)
#define PG8_WAIT_V(n) asm volatile("s_waitcnt vmcnt(" #n ")" ::: "memory")
#define PG8_WAIT_L(n) asm volatile("s_waitcnt lgkmcnt(" #n ")" ::: "memory")
#define PG8_BAR __builtin_amdgcn_s_barrier()
#define PG8_SCHED __builtin_amdgcn_sched_barrier(0)
    Unit cur, nxt; int ui = 0;
    if (!unit_next(g, 0, cur)) return;
    f32x4 acc[2][2][4][2];
#pragma unroll
    for (int a = 0; a < 2; ++a)
#pragma unroll
        for (int b = 0; b < 2; ++b)
#pragma unroll
            for (int m = 0; m < 4; ++m)
#pragma unroll
                for (int n = 0; n < 2; ++n) acc[a][b][m][n] = (f32x4){0.f, 0.f, 0.f, 0.f};
    bf16x8 At[4][2], B0[2][2], B1[2][2];
    const char* cA = unit_a(g, cur); const char* cB = unit_b(g, cur);
    PG8_STAGE(PG8_SB(0, 0), cB, voffB); PG8_STAGE(PG8_SA(0, 0), cA, voffA); PG8_STAGE(PG8_SB(0, 1), cB + hstepB, voffB); PG8_STAGE(PG8_SA(0, 1), cA + hstepA, voffA);
    if (wr == 1) PG8_BAR;
    PG8_WAIT_V(4); PG8_BAR;
    PG8_STAGE(PG8_SB(1, 0), cB + kstep, voffB); PG8_STAGE(PG8_SA(1, 0), cA + kstep, voffA); PG8_STAGE(PG8_SB(1, 1), cB + hstepB + kstep, voffB);
    PG8_WAIT_V(6); PG8_BAR;
    for (;;) {
        const bool has_next = unit_next(g, ui + 1, nxt);
        const char* nA = has_next ? unit_a(g, nxt) : cA; const char* nB = has_next ? unit_b(g, nxt) : cB;
        for (int t = 0; t < nt; t += 2) {
            const bool last = (t == nt - 2);
            const char* a1 = cA + (size_t)(t + 1) * kstep;
            const char* a2 = last ? nA : cA + (size_t)(t + 2) * kstep; const char* b2 = last ? nB : cB + (size_t)(t + 2) * kstep;
            const char* a3 = a2 + kstep; const char* b3 = b2 + kstep;
            PG8_LDB(B0, 0, 0); PG8_SCHED; PG8_LDA(At, 0, 0); PG8_STAGE(PG8_SA(1, 1), a1 + hstepA, voffA);
            PG8_WAIT_L(8); PG8_BAR; PG8_WAIT_L(0); PG8_MMA(0, 0, At, B0); PG8_BAR; PG8_SCHED;
            PG8_LDB(B1, 0, 1); PG8_STAGE(PG8_SB(0, 0), b2, voffB);
            PG8_BAR; PG8_WAIT_L(0); PG8_MMA(0, 1, At, B1); PG8_BAR;
            PG8_LDA(At, 0, 1); PG8_STAGE(PG8_SA(0, 0), a2, voffA);
            PG8_BAR; PG8_WAIT_L(0); PG8_MMA(1, 0, At, B0); PG8_BAR; PG8_SCHED;
            PG8_STAGE(PG8_SB(0, 1), b2 + hstepB, voffB);
            PG8_WAIT_V(6); PG8_BAR; PG8_MMA(1, 1, At, B1); PG8_BAR;
            PG8_LDB(B0, 1, 0); PG8_SCHED; PG8_LDA(At, 1, 0); PG8_STAGE(PG8_SA(0, 1), a2 + hstepA, voffA);
            PG8_WAIT_L(8); PG8_BAR; PG8_WAIT_L(0); PG8_MMA(0, 0, At, B0); PG8_BAR; PG8_SCHED;
            PG8_LDB(B1, 1, 1); PG8_STAGE(PG8_SB(1, 0), b3, voffB);
            PG8_BAR; PG8_WAIT_L(0); PG8_MMA(0, 1, At, B1); PG8_BAR;
            PG8_LDA(At, 1, 1); PG8_STAGE(PG8_SA(1, 0), a3, voffA);
            PG8_BAR; PG8_WAIT_L(0); PG8_MMA(1, 0, At, B0); PG8_BAR; PG8_SCHED;
            PG8_STAGE(PG8_SB(1, 1), b3 + hstepB, voffB);
            PG8_WAIT_V(6); PG8_BAR; PG8_MMA(1, 1, At, B1); PG8_BAR;
        }
        epilogue(acc, g, P, cur, wr, wc, fr, fq);
        if (!has_next) break;
#pragma unroll
        for (int a = 0; a < 2; ++a)
#pragma unroll
            for (int b = 0; b < 2; ++b)
#pragma unroll
                for (int m = 0; m < 4; ++m)
#pragma unroll
                    for (int n = 0; n < 2; ++n) acc[a][b][m][n] = (f32x4){0.f, 0.f, 0.f, 0.f};
        cur = nxt; cA = nA; cB = nB; ++ui;
    }
    PG8_WAIT_V(0);
    if (wr == 0) PG8_BAR;
    PG8_BAR;
}

__device__ void convT(LAS unsigned* T, const float* __restrict__ src, bf16_t* __restrict__ dst, int K, int N, const float* kg, const float* ns, int& job) {
    const int tid = otid(), kp = tid >> 4, c4 = (tid & 15) * 4, nb = gridDim.x, bid = blockIdx.x;
    const int nct = (N + 255) / 256, ntiles = (K / 64) * nct;
    const int first = ((bid - job) % nb + nb) % nb;
    for (int ti = first; ti < ntiles; ti += nb) {
        const int kt = ti / nct, ct = ti - kt * nct, k0 = kt * 64, n0 = ct * 256;
        const int nq = min(4, (N - n0) / 64);
        float4 a[4], b[4];
        const float g0 = kg ? kg[k0 + 2 * kp] : 1.f, g1 = kg ? kg[k0 + 2 * kp + 1] : 1.f;
#pragma unroll
        for (int q = 0; q < 4; ++q) if (q < nq) {
            a[q] = *(const float4*)(src + (size_t)(k0 + 2 * kp) * N + n0 + q * 64 + c4);
            b[q] = *(const float4*)(src + (size_t)(k0 + 2 * kp + 1) * N + n0 + q * 64 + c4);
        }
#pragma unroll
        for (int q = 0; q < 4; ++q) if (q < nq) {
            float4 s = make_float4(1.f, 1.f, 1.f, 1.f);
            if (ns) s = *(const float4*)(ns + n0 + q * 64 + c4);
            const int nn = q * 64 + c4;
            T[(nn + 0) * 33 + kp] = cvt_pk_bf16(a[q].x * g0 * s.x, b[q].x * g1 * s.x);
            T[(nn + 1) * 33 + kp] = cvt_pk_bf16(a[q].y * g0 * s.y, b[q].y * g1 * s.y);
            T[(nn + 2) * 33 + kp] = cvt_pk_bf16(a[q].z * g0 * s.z, b[q].z * g1 * s.z);
            T[(nn + 3) * 33 + kp] = cvt_pk_bf16(a[q].w * g0 * s.w, b[q].w * g1 * s.w);
        }
        __syncthreads();
        for (int i = tid; i < nq * 512; i += 512) {
            const int n = i >> 3, ch = i & 7;
            u32x4 w; w.x = T[n * 33 + ch * 4]; w.y = T[n * 33 + ch * 4 + 1]; w.z = T[n * 33 + ch * 4 + 2]; w.w = T[n * 33 + ch * 4 + 3];
            *(u32x4*)(dst + (size_t)(n0 + n) * K + k0 + ch * 8) = w;
        }
        __syncthreads();
    }
    job = (job + ntiles) % nb;
}

__device__ void rows_to_bf16(const float* __restrict__ src, int nrows, bf16_t* __restrict__ dstb, float* __restrict__ ssp) {
    const int tid = otid(), lane = tid & 63, gw = blockIdx.x * 8 + (tid >> 6), nw = gridDim.x * 8;
    for (int r = gw; r < nrows; r += nw) {
        const float* sp = src + (size_t)r * 2048; bf16_t* dp = dstb + (size_t)r * 2048;
        float4 v[8];
#pragma unroll
        for (int i = 0; i < 8; ++i) v[i] = *(const float4*)(sp + (i * 64 + lane) * 4);
        float ss = 0.f;
#pragma unroll
        for (int i = 0; i < 8; ++i) {
            ss += (v[i].x * v[i].x + v[i].y * v[i].y) + (v[i].z * v[i].z + v[i].w * v[i].w);
            u32x2 w; w.x = cvt_pk_bf16(v[i].x, v[i].y); w.y = cvt_pk_bf16(v[i].z, v[i].w);
            *(u32x2*)(dp + (i * 64 + lane) * 4) = w;
        }
        const float t = ss + __shfl_xor(ss, 32);
        if (lane < 32) ssp[(size_t)r * 32 + lane] = t;
    }
}

__device__ void pool_diff(const Params& P) {
    const float* U = (const float*)(P.ws + WS_BIG + BG_U); bf16_t* Dd = (bf16_t*)(P.ws + WS_BIG + BG_D);
    const float* cpool = P.in[I_CPOOL];
    const size_t total = (size_t)MT * 384;
    const int tid = otid();
    for (size_t i = (size_t)blockIdx.x * 512 + tid; i < total; i += (size_t)gridDim.x * 512) {
        const int r = (int)(i / 384), c = (int)(i - (size_t)r * 384) * 4;
        const int g = c / 384, w = 2 << g;
        const bool isp = r < MP;
        const int b = isp ? (r >> 12) : ((r - MP) >> 5), t = isp ? (r & 4095) : ((r - MP) & 31);
        const f32x4 cur = *(const f32x4*)(U + (size_t)r * 1536 + c);
        f32x4 sum = cur;
        for (int j = 1; j < w; ++j) {
            const int tt = t - j;
            if (tt >= 0) sum += *(const f32x4*)(U + (size_t)(r - j) * 1536 + c);
            else if (!isp) sum += *(const f32x4*)(cpool + (size_t)(b * 15 + 15 + tt) * 1536 + c);
        }
        const float cnt = isp ? (float)min(t + 1, w) : (float)w;
        const f32x4 d = sum / cnt - cur;
        u32x2 o; o.x = cvt_pk_bf16(d[0], d[1]); o.y = cvt_pk_bf16(d[2], d[3]);
        *(u32x2*)(Dd + (size_t)r * 1536 + c) = o;
        if (isp) { if (t >= SEQ - 15) *(f32x4*)(P.out + O_PP + (size_t)(b * 15 + t - (SEQ - 15)) * 1536 + c) = cur; }
        else { if (t >= DSEQ - 15) *(f32x4*)(P.out + O_PS + (size_t)(b * 15 + t - (DSEQ - 15)) * 1536 + c) = cur; }
    }
}

__device__ void memkv_finalize(const Params& P) {
    const int tid = otid(), lane = tid & 63, gw = blockIdx.x * 8 + (tid >> 6), nw = gridDim.x * 8;
    const float* KV = (const float*)(P.ws + WS_KV);
    bf16_t* MK = (bf16_t*)(P.ws + WS_MK); bf16_t* MV = (bf16_t*)(P.ws + WS_MV);
    for (int it = gw; it < 2048; it += nw) {
        const int layer = it >> 10, row = it & 1023;
        const float* sp = KV + ((size_t)layer * 1024 + row) * 1024 + lane * 16;
        f32x4 v[4];
#pragma unroll
        for (int i = 0; i < 4; ++i) v[i] = *(const f32x4*)(sp + i * 4);
        float ss = 0.f;
#pragma unroll
        for (int i = 0; i < 4; ++i) ss += (v[i][0] * v[i][0] + v[i][1] * v[i][1]) + (v[i][2] * v[i][2] + v[i][3] * v[i][3]);
        ss += __shfl_xor(ss, 1); ss += __shfl_xor(ss, 2); ss += __shfl_xor(ss, 4);
        const float rs = rsqrtf(ss * (1.0f / 128.0f) + EPS);
        const bool isk = lane < 32;
        const int col = (lane & 31) * 16;
        const float* gn = P.in[I_KN] + layer * 128 + (col & 127);
        float* of = P.out + (isk ? O_MK : O_MV) + ((size_t)layer * 1024 + row) * 512 + col;
        bf16_t* ob = (isk ? MK : MV) + ((size_t)layer * 5120 + row) * 512 + col;
#pragma unroll
        for (int i = 0; i < 4; ++i) {
            f32x4 y = v[i];
            if (isk) { const f32x4 gg = *(const f32x4*)(gn + i * 4); y = y * rs * gg; }
            *(f32x4*)(of + i * 4) = y;
            u32x2 w; w.x = cvt_pk_bf16(y[0], y[1]); w.y = cvt_pk_bf16(y[2], y[3]);
            *(u32x2*)(ob + i * 4) = w;
        }
    }
}

DI bf16x8 tr_frag(LAS unsigned char* base, int off) {
    const s16x4 a = __builtin_amdgcn_ds_read_tr16_b64_v4i16((LAS s16x4*)(base + off));
    const s16x4 b = __builtin_amdgcn_ds_read_tr16_b64_v4i16((LAS s16x4*)(base + off + 8 * 320));
    bf16x8 r; r[0] = a[0]; r[1] = a[1]; r[2] = a[2]; r[3] = a[3]; r[4] = b[0]; r[5] = b[1]; r[6] = b[2]; r[7] = b[3]; return r;
}
DI bf16x8 pack8(const f32x16& p, int s) {
    u32x4 w; w.x = cvt_pk_bf16(p[8 * s + 0], p[8 * s + 1]); w.y = cvt_pk_bf16(p[8 * s + 2], p[8 * s + 3]);
    w.z = cvt_pk_bf16(p[8 * s + 4], p[8 * s + 5]); w.w = cvt_pk_bf16(p[8 * s + 6], p[8 * s + 7]);
    return __builtin_bit_cast(bf16x8, w);
}

__device__ void mem_attn(LAS unsigned char* lds, const Params& P, int layer) {
    const int tid = otid(), wid = __builtin_amdgcn_readfirstlane(tid >> 6), lane = tid & 63, qi = lane & 31, hh = lane >> 5;
    const bf16_t* QM = (const bf16_t*)(P.ws + WS_BIG + BG_QM);
    const bf16_t* MK = (const bf16_t*)(P.ws + WS_MK) + (size_t)layer * 20 * 256 * 512;
    const bf16_t* MV = (const bf16_t*)(P.ws + WS_MV) + (size_t)layer * 20 * 256 * 512;
    bf16_t* CAT = (bf16_t*)(P.ws + WS_BIG + BG_CAT);
    const float* qg = P.in[I_QN] + layer * 128;
    LAS unsigned char* Kl = lds; LAS unsigned char* Vl = lds + 256 * 272;
    for (int it = blockIdx.x; it < 320; it += gridDim.x) {
        int bb, hd, rowbase; bool active;
        if (it < 256) { const int b = it >> 6, h = (it >> 4) & 3, ch = it & 15; bb = b; hd = h; rowbase = b * SEQ + ch * 256 + wid * 32; active = true; }
        else { const int j = it - 256, b = j >> 2, h = j & 3; bb = 4 + b; hd = h; rowbase = MP + b * DSEQ; active = (wid == 0); }
        const bf16_t* ks = MK + (size_t)bb * 256 * 512 + hd * 128; const bf16_t* vs = MV + (size_t)bb * 256 * 512 + hd * 128;
#pragma unroll
        for (int i = 0; i < 8; ++i) {
            const int c = i * 512 + tid, row = c >> 4, ch = c & 15;
            const u32x4 kv = *(const u32x4*)(ks + (size_t)row * 512 + ch * 8);
            const u32x4 vv = *(const u32x4*)(vs + (size_t)row * 512 + ch * 8);
            *(LAS u32x4*)(Kl + row * 272 + ch * 16) = kv;
            *(LAS u32x4*)(Vl + row * 320 + ch * 16) = vv;
        }
        __syncthreads();
        if (active) {
            bf16x8 qf[8]; float ss = 0.f;
            const bf16_t* qp = QM + (size_t)(rowbase + qi) * 512 + hd * 128 + hh * 8;
#pragma unroll
            for (int s = 0; s < 8; ++s) {
                const u32x4 raw = *(const u32x4*)(qp + s * 16);
                const f32x4 g0 = *(const f32x4*)(qg + s * 16 + hh * 8), g1 = *(const f32x4*)(qg + s * 16 + hh * 8 + 4);
                float q0 = bf_lo(raw.x), q1 = bf_hi(raw.x), q2 = bf_lo(raw.y), q3 = bf_hi(raw.y), q4 = bf_lo(raw.z), q5 = bf_hi(raw.z), q6 = bf_lo(raw.w), q7 = bf_hi(raw.w);
                ss += (q0 * q0 + q1 * q1) + (q2 * q2 + q3 * q3) + (q4 * q4 + q5 * q5) + (q6 * q6 + q7 * q7);
                u32x4 w; w.x = cvt_pk_bf16(q0 * g0[0], q1 * g0[1]); w.y = cvt_pk_bf16(q2 * g0[2], q3 * g0[3]); w.z = cvt_pk_bf16(q4 * g1[0], q5 * g1[1]); w.w = cvt_pk_bf16(q6 * g1[2], q7 * g1[3]);
                qf[s] = __builtin_bit_cast(bf16x8, w);
            }
            ss += __shfl_xor(ss, 32);
            const float scale = rsqrtf(ss * (1.0f / 128.0f) + EPS) * 0.08838834764831845f * 1.4426950408889634f;
            float m_run = -1e30f, l_run = 0.f;
            f32x16 O[4];
#pragma unroll
            for (int d = 0; d < 4; ++d)
#pragma unroll
                for (int i = 0; i < 16; ++i) O[d][i] = 0.f;
            LAS unsigned char* vtb = Vl + (4 * hh + ((lane & 15) >> 2)) * 320 + (16 * ((lane >> 4) & 1) + 4 * (lane & 3)) * 2;
            for (int kt = 0; kt < 8; ++kt) {
                f32x16 S;
#pragma unroll
                for (int i = 0; i < 16; ++i) S[i] = 0.f;
#pragma unroll
                for (int s = 0; s < 8; ++s) {
                    const bf16x8 kf = *(const LAS bf16x8*)(Kl + (kt * 32 + qi) * 272 + (16 * s + 8 * hh) * 2);
                    S = __builtin_amdgcn_mfma_f32_32x32x16_bf16(kf, qf[s], S, 0, 0, 0);
                }
                float tmax = -1e30f;
#pragma unroll
                for (int i = 0; i < 16; ++i) { S[i] *= scale; tmax = fmaxf(tmax, S[i]); }
                tmax = fmaxf(tmax, __shfl_xor(tmax, 32));
                const float m_new = fmaxf(m_run, tmax), alpha = exp2f(m_run - m_new); m_run = m_new;
                float lsum = 0.f;
#pragma unroll
                for (int i = 0; i < 16; ++i) { S[i] = exp2f(S[i] - m_new); lsum += S[i]; }
                l_run = l_run * alpha + lsum;
#pragma unroll
                for (int d = 0; d < 4; ++d)
#pragma unroll
                    for (int i = 0; i < 16; ++i) O[d][i] *= alpha;
                const bf16x8 p0 = pack8(S, 0), p1 = pack8(S, 1);
#pragma unroll
                for (int d = 0; d < 4; ++d) {
                    const bf16x8 v0 = tr_frag(vtb, (kt * 32) * 320 + d * 64), v1 = tr_frag(vtb, (kt * 32 + 16) * 320 + d * 64);
                    O[d] = __builtin_amdgcn_mfma_f32_32x32x16_bf16(v0, p0, O[d], 0, 0, 0);
                    O[d] = __builtin_amdgcn_mfma_f32_32x32x16_bf16(v1, p1, O[d], 0, 0, 0);
                }
            }
            l_run += __shfl_xor(l_run, 32);
            const float inv = 1.0f / l_run;
            bf16_t* op = CAT + (size_t)(rowbase + qi) * 2048 + 1536 + hd * 128 + 4 * hh;
#pragma unroll
            for (int d = 0; d < 4; ++d)
#pragma unroll
                for (int gq = 0; gq < 4; ++gq) {
                    u32x2 w; w.x = cvt_pk_bf16(O[d][4 * gq] * inv, O[d][4 * gq + 1] * inv); w.y = cvt_pk_bf16(O[d][4 * gq + 2] * inv, O[d][4 * gq + 3] * inv);
                    *(u32x2*)(op + 32 * d + 8 * gq) = w;
                }
        }
        __syncthreads();
    }
}

DI bf16x8 ld_frag_f32(const float* p) {
    const f32x4 a = *(const f32x4*)p, b = *(const f32x4*)(p + 4);
    u32x4 w; w.x = cvt_pk_bf16(a[0], a[1]); w.y = cvt_pk_bf16(a[2], a[3]); w.z = cvt_pk_bf16(b[0], b[1]); w.w = cvt_pk_bf16(b[2], b[3]);
    return __builtin_bit_cast(bf16x8, w);
}

__device__ void sb_item(LAS unsigned char* vl, const Params& P, int lane, bool sample, int b, int h, int qt) {
    const int qi = lane & 31, hh = lane >> 5;
    const bf16_t* Qb = (const bf16_t*)(P.ws + WS_BIG + BG_Q); const bf16_t* Kb = (const bf16_t*)(P.ws + WS_BIG + BG_K); const bf16_t* Vb = (const bf16_t*)(P.ws + WS_BIG + BG_V);
    bf16_t* CAT = (bf16_t*)(P.ws + WS_BIG + BG_CAT);
    const int rowbase = sample ? (MP + b * DSEQ) : (b * SEQ + qt * 32);
    const int kt_hi = sample ? (PAST / 32) : qt;
    bf16x8 qf[8];
    { const bf16_t* qp = Qb + (size_t)(rowbase + qi) * 1536 + h * 128 + hh * 8;
#pragma unroll
      for (int s = 0; s < 8; ++s) qf[s] = *(const bf16x8*)(qp + s * 16); }
    f32x16 O[4];
#pragma unroll
    for (int d = 0; d < 4; ++d)
#pragma unroll
        for (int i = 0; i < 16; ++i) O[d][i] = 0.f;
    float C = 0.f;
    LAS unsigned char* vtb = vl + (4 * hh + ((lane & 15) >> 2)) * 320 + (16 * ((lane >> 4) & 1) + 4 * (lane & 3)) * 2;
    for (int kt = kt_hi; kt >= 0; --kt) {
        const bool diag = (kt == kt_hi);
        const bool from_cache = sample && !diag;
        f32x16 S;
#pragma unroll
        for (int i = 0; i < 16; ++i) S[i] = 0.f;
        if (from_cache) {
            const float* kp = P.in[I_CSBK] + ((size_t)(b * PAST + kt * 32 + qi)) * 1536 + h * 128 + hh * 8;
            const float* vp = P.in[I_CSBV] + ((size_t)(b * PAST + kt * 32)) * 1536 + h * 128;
#pragma unroll
            for (int i = 0; i < 8; ++i) { const int c = i * 64 + lane, row = c >> 4, ch = c & 15;
                const bf16x8 v = ld_frag_f32(vp + (size_t)row * 1536 + ch * 8);
                *(LAS bf16x8*)(vl + row * 320 + ch * 16) = v; }
#pragma unroll
            for (int s = 0; s < 8; ++s) { const bf16x8 kf = ld_frag_f32(kp + s * 16); S = __builtin_amdgcn_mfma_f32_32x32x16_bf16(kf, qf[s], S, 0, 0, 0); }
        } else {
            const int krow = sample ? (MP + b * DSEQ) : (b * SEQ + kt * 32);
            const bf16_t* kp = Kb + (size_t)(krow + qi) * 1536 + h * 128 + hh * 8;
            const bf16_t* vp = Vb + (size_t)krow * 1536 + h * 128;
#pragma unroll
            for (int i = 0; i < 8; ++i) { const int c = i * 64 + lane, row = c >> 4, ch = c & 15;
                const bf16x8 v = *(const bf16x8*)(vp + (size_t)row * 1536 + ch * 8);
                *(LAS bf16x8*)(vl + row * 320 + ch * 16) = v; }
#pragma unroll
            for (int s = 0; s < 8; ++s) { const bf16x8 kf = *(const bf16x8*)(kp + s * 16); S = __builtin_amdgcn_mfma_f32_32x32x16_bf16(kf, qf[s], S, 0, 0, 0); }
        }
        float lf[16], ls[16];
#pragma unroll
        for (int i = 0; i < 16; ++i) {
            const float z = S[i] * 0.08838834764831845f;
            const int j = (i & 3) + 8 * (i >> 2) + 4 * hh;
            const bool valid = !diag || (j < qi);
            const float sp = fmaxf(z, 0.f) + __logf(1.0f + __expf(-fabsf(z)));
            lf[i] = valid ? -sp : 0.f;
            ls[i] = valid ? (z - sp) : -1e30f;
        }
        float G[4], Gp[4], T[4];
#pragma unroll
        for (int gq = 0; gq < 4; ++gq) { G[gq] = (lf[4 * gq] + lf[4 * gq + 1]) + (lf[4 * gq + 2] + lf[4 * gq + 3]); Gp[gq] = __shfl_xor(G[gq], 32); }
        float run = 0.f;
#pragma unroll
        for (int gq = 3; gq >= 0; --gq) { T[gq] = run + (hh == 0 ? Gp[gq] : 0.f); run += G[gq] + Gp[gq]; }
#pragma unroll
        for (int gq = 0; gq < 4; ++gq) {
            float af = T[gq] + C;
#pragma unroll
            for (int r = 3; r >= 0; --r) { const int i = 4 * gq + r; S[i] = __expf(ls[i] + af); af += lf[i]; }
        }
        C += run;
        const bf16x8 p0 = pack8(S, 0), p1 = pack8(S, 1);
#pragma unroll
        for (int d = 0; d < 4; ++d) {
            const bf16x8 v0 = tr_frag(vtb, d * 64), v1 = tr_frag(vtb, 16 * 320 + d * 64);
            O[d] = __builtin_amdgcn_mfma_f32_32x32x16_bf16(v0, p0, O[d], 0, 0, 0);
            O[d] = __builtin_amdgcn_mfma_f32_32x32x16_bf16(v1, p1, O[d], 0, 0, 0);
        }
        if (__builtin_amdgcn_ballot_w64(C > -110.0f) == 0ull) break;
    }
    bf16_t* op = CAT + (size_t)(rowbase + qi) * 2048 + h * 128 + 4 * hh;
#pragma unroll
    for (int d = 0; d < 4; ++d)
#pragma unroll
        for (int gq = 0; gq < 4; ++gq) {
            u32x2 w; w.x = cvt_pk_bf16(O[d][4 * gq], O[d][4 * gq + 1]); w.y = cvt_pk_bf16(O[d][4 * gq + 2], O[d][4 * gq + 3]);
            *(u32x2*)(op + 32 * d + 8 * gq) = w;
        }
}

__device__ void sb_attn(LAS unsigned char* lds, const Params& P) {
    const int tid = otid(), wid = __builtin_amdgcn_readfirstlane(tid >> 6), lane = tid & 63;
    LAS unsigned char* vl = lds + wid * 10240;
    const int gw = blockIdx.x * 8 + wid, nw = gridDim.x * 8;
#pragma unroll 1
    for (int k = 0; k < 1 + (4 * NSBH * 128 + nw - 1) / nw; ++k) {
        bool sample; int b, h, qt;
        if (k == 0) { if (wid != 0 || (int)blockIdx.x >= 16 * NSBH) continue; sample = true; b = blockIdx.x / NSBH; h = blockIdx.x % NSBH; qt = 0; }
        else { const int j = (k - 1) * nw + gw; if (j >= 4 * NSBH * 128) continue; const int bh = j >> 7; sample = false; b = bh / NSBH; h = bh % NSBH; qt = j & 127; }
        sb_item(vl, P, lane, sample, b, h, qt);
    }
}

__device__ void prologue(LAS unsigned char* lds, const Params& P) {
    unsigned char* ws = P.ws;
    int job = 0; LAS unsigned* T = (LAS unsigned*)lds;
#pragma unroll 1
    for (int wi = 0; wi < 16; ++wi) {
        const float* src; bf16_t* dst; int K, N; const float* kg = nullptr; const float* ns = nullptr;
        if (wi == 0) { src = P.in[I_WINP]; dst = (bf16_t*)(ws + WS_WINP); K = 2048; N = 2048; kg = P.in[I_NMIX]; }
        else if (wi < 3) { const int l = wi - 1; src = P.in[I_WKV] + (size_t)l * 2048 * 1024; dst = (bf16_t*)(ws + WS_WKV) + (size_t)l * 1024 * 2048; K = 2048; N = 1024; kg = P.in[I_NMEM] + l * 2048; }
        else if (wi < 7) { const int gq = wi - 3; src = P.in[I_POOLW] + (size_t)gq * 384 * 384; dst = (bf16_t*)(ws + WS_POOLW) + (size_t)gq * 512 * 384; K = 384; N = 384; ns = P.in[I_PSCALE] + gq * 384; }
        else if (wi < 9) { const int l = wi - 7; src = P.in[I_WOUT] + (size_t)l * 2048 * 2048; dst = (bf16_t*)(ws + WS_WOUT) + (size_t)l * 2048 * 2048; K = 2048; N = 2048; }
        else if (wi < 11) { const int l = wi - 9; src = P.in[I_WUP] + (size_t)l * 2048 * 8192; dst = (bf16_t*)(ws + WS_WUP) + (size_t)l * 8192 * 2048; K = 2048; N = 8192; kg = P.in[I_NFFN] + l * 2048; }
        else if (wi < 13) { const int l = wi - 11; src = P.in[I_WDOWN] + (size_t)l * 8192 * 2048; dst = (bf16_t*)(ws + WS_WDOWN) + (size_t)l * 2048 * 8192; K = 8192; N = 2048; }
        else if (wi == 13) { src = P.in[I_WINS]; dst = (bf16_t*)(ws + WS_WINS); K = 2048; N = 5120; kg = P.in[I_NMIX] + 2048; }
        else continue;
        convT(T, src, dst, K, N, kg, ns, job);
    }
#pragma unroll 1
    for (int ri = 0; ri < 3; ++ri) {
        const float* src = ri == 0 ? P.in[I_XP] : (ri == 1 ? P.in[I_XS] : P.in[I_MEM]);
        const int nrows = ri == 0 ? MP : (ri == 1 ? MS : NMT);
        bf16_t* db = ri == 0 ? (bf16_t*)(ws + WS_XB) : (ri == 1 ? (bf16_t*)(ws + WS_XB) + (size_t)MP * 2048 : (bf16_t*)(ws + WS_MB));
        float* sp = ri == 0 ? (float*)(ws + WS_SSP) : (ri == 1 ? (float*)(ws + WS_SSP) + (size_t)MP * 32 : (float*)(ws + WS_SSPM));
        rows_to_bf16(src, nrows, db, sp);
    }
#pragma unroll 1
    for (int l = 0; l < 2; ++l) {
        const size_t n4 = (size_t)16 * 256 * 512 / 4;
        const int tid = otid();
        for (size_t i = (size_t)blockIdx.x * 512 + tid; i < 2 * n4; i += (size_t)gridDim.x * 512) {
            const bool isv = i >= n4; const size_t e = (isv ? i - n4 : i) * 4;
            const f32x4 v = *(const f32x4*)(P.in[isv ? I_CMV : I_CMK] + (size_t)l * 16 * 256 * 512 + e);
            u32x2 w; w.x = cvt_pk_bf16(v[0], v[1]); w.y = cvt_pk_bf16(v[2], v[3]);
            *(u32x2*)((bf16_t*)(ws + (isv ? WS_MV : WS_MK)) + ((size_t)l * 20 + 4) * 256 * 512 + e) = w;
        }
    }
}

DI int step_ngemm(int step) { return step == 1 ? 3 : ((step == 0 || step == 2 || step == 8) ? 0 : 1); }
DI GemmJob step_job(const Params& P, int step, int gi) {
    unsigned char* ws = P.ws; GemmJob g{};
    g.lda = 2048; g.ldb = 2048; g.K = 2048; g.nM = 66; g.nN = 8;
    const int layer = step >= 7 ? 1 : 0;
    if (step == 1) {
        if (gi == 0) { g.A = (const bf16_t*)(ws + WS_XB); g.Bt = (const bf16_t*)(ws + WS_WINP); g.mode = MODE_INPOOL; }
        else { const int l = gi - 1; g.A = (const bf16_t*)(ws + WS_MB); g.Bt = (const bf16_t*)(ws + WS_WKV) + (size_t)l * 1024 * 2048; g.nM = 4; g.nN = 4; g.mode = MODE_KV; g.layer = l; g.coff = 16 + 16 * l; }
    } else if (step == 3) { g.A = (const bf16_t*)(ws + WS_BIG + BG_D); g.Bt = (const bf16_t*)(ws + WS_POOLW); g.lda = 1536; g.ldb = 384; g.K = 384; g.mode = MODE_POOL; }
    else if (step == 4 || step == 9) { g.A = (const bf16_t*)(ws + WS_BIG + BG_CAT); g.Bt = (const bf16_t*)(ws + WS_WOUT) + (size_t)layer * 2048 * 2048; g.mode = MODE_RESID; g.layer = layer; }
    else if (step == 5 || step == 10) { g.A = (const bf16_t*)(ws + WS_XB); g.Bt = (const bf16_t*)(ws + WS_WUP) + (size_t)layer * 8192 * 2048; g.nN = 32; g.mode = MODE_UP; }
    else if (step == 6 || step == 11) { g.A = (const bf16_t*)(ws + WS_BIG); g.Bt = (const bf16_t*)(ws + WS_WDOWN) + (size_t)layer * 2048 * 8192; g.lda = 8192; g.ldb = 8192; g.K = 8192; g.mode = MODE_RESID; g.layer = 1; g.last = layer; }
    else { g.A = (const bf16_t*)(ws + WS_XB); g.Bt = (const bf16_t*)(ws + WS_WINS); g.nN = 20; g.mode = MODE_INSB; }
    return g;
}

__global__ void __launch_bounds__(512, 2) fwd_megakernel(Params P) {
    extern __shared__ __attribute__((aligned(16))) unsigned char smem[];
    LAS unsigned char* lds = (LAS unsigned char*)smem;
    cg::grid_group grid = cg::this_grid();
#pragma unroll 1
    for (int step = 0; step < 12; ++step) {
        if (step == 0) prologue(lds, P);
        if (step == 2) { pool_diff(P); memkv_finalize(P); }
        if (step == 8) sb_attn(lds, P);
        const int ng = step_ngemm(step);
#pragma unroll 1
        for (int gi = 0; gi < ng; ++gi) { const GemmJob g = step_job(P, step, gi); gemm_phase(lds, g, P); }
        if (step == 3 || step == 8) { __syncthreads(); mem_attn(lds, P, step == 8 ? 1 : 0); }
        if (step < 11) grid.sync();
    }
}

extern "C" void kernel_launch(void* const* d_in, const int* in_sizes, int n_in, void* d_out, int out_size, void* d_ws, size_t ws_size, hipStream_t stream) {
    static int state = 0;
    if (state == 0) {
        state = 1;
        if (n_in != 21 || ws_size < WS_END) { fprintf(stderr, "kernel_launch: need 21 inputs and %zu bytes of workspace (got %d, %zu)\n", (size_t)WS_END, n_in, ws_size); state = -1; }
        if (hipFuncSetAttribute((const void*)fwd_megakernel, hipFuncAttributeMaxDynamicSharedMemorySize, LDS_BYTES) != hipSuccess) { fprintf(stderr, "kernel_launch: hipFuncSetAttribute failed\n"); state = -1; }
        int per_cu = 0;
        if (hipOccupancyMaxActiveBlocksPerMultiprocessor(&per_cu, (const void*)fwd_megakernel, 512, LDS_BYTES) != hipSuccess || per_cu < 1) fprintf(stderr, "kernel_launch: occupancy query reports %d blocks per CU\n", per_cu);
        (void)hipGetLastError();
    }
    if (state < 0) return;
    Params p{};
    for (int i = 0; i < 21; ++i) p.in[i] = (const float*)d_in[i];
    p.out = (float*)d_out; p.ws = (unsigned char*)d_ws;
    void* args[] = {&p};
    hipError_t e = hipLaunchCooperativeKernel((const void*)fwd_megakernel, dim3(256), dim3(512), args, LDS_BYTES, stream);
    if (e != hipSuccess) fprintf(stderr, "cooperative launch failed: %s\n", hipGetErrorString(e));
}
```

```cpp
#include <hip/hip_runtime.h>
#include <hip/hip_cooperative_groups.h>
#include <cstdio>
namespace cg = cooperative_groups;

#define LAS __attribute__((address_space(3)))
#define DI __device__ __forceinline__
typedef unsigned short bf16_t;
typedef short bf16x8 __attribute__((ext_vector_type(8)));
typedef short s16x4 __attribute__((ext_vector_type(4)));
typedef float f32x4 __attribute__((ext_vector_type(4)));
typedef float f32x16 __attribute__((ext_vector_type(16)));
typedef unsigned u32x4 __attribute__((ext_vector_type(4)));
typedef unsigned u32x2 __attribute__((ext_vector_type(2)));

constexpr int DM = 2048, MP = 16384, MS = 512, MT = 16896, NMT = 1024, DTOK = 1536, DMEM = 512, DFF = 8192;
constexpr int SEQ = 4096, DSEQ = 32, PAST = 1024, NSBH = 12, HD = 128;
constexpr float EPS = 1e-6f;
constexpr size_t O_Y = 0, O_PP = 34603008, O_PS = O_PP + 92160, O_SKP = O_PS + 368640, O_SVP = O_SKP + 25165824,
                 O_SKS = O_SVP + 25165824, O_SVS = O_SKS + 786432, O_MK = O_SVS + 786432, O_MV = O_MK + 1048576;
constexpr size_t WS_WINP = 0;
constexpr size_t WS_WINS = WS_WINP + (size_t)2048 * 2048 * 2;
constexpr size_t WS_POOLW = WS_WINS + (size_t)5120 * 2048 * 2;
constexpr size_t WS_WKV = WS_POOLW + (size_t)4 * 512 * 384 * 2;
constexpr size_t WS_WOUT = WS_WKV + (size_t)2 * 1024 * 2048 * 2;
constexpr size_t WS_WUP = WS_WOUT + (size_t)2 * 2048 * 2048 * 2;
constexpr size_t WS_WDOWN = WS_WUP + (size_t)2 * 8192 * 2048 * 2;
constexpr size_t WS_XB = WS_WDOWN + (size_t)2 * 2048 * 8192 * 2;
constexpr size_t WS_MB = WS_XB + (size_t)MT * 2048 * 2;
constexpr size_t WS_SSP = WS_MB + (size_t)NMT * 2048 * 2;
constexpr size_t WS_SSPM = WS_SSP + (size_t)MT * 32 * 4;
constexpr size_t WS_KV = WS_SSPM + (size_t)NMT * 32 * 4;
constexpr size_t WS_MK = WS_KV + (size_t)2 * 1024 * 1024 * 4;
constexpr size_t WS_MV = WS_MK + (size_t)2 * 20 * 256 * 512 * 2;
constexpr size_t WS_BIG = WS_MV + (size_t)2 * 20 * 256 * 512 * 2;
constexpr size_t WS_PART = WS_BIG + (size_t)MT * 8192 * 2;
constexpr size_t WS_END = WS_PART + (size_t)16 * 512 * 2048 * 4;
constexpr size_t BG_U = 0, BG_D = (size_t)MT * 1536 * 4, BG_QM = BG_D + (size_t)MT * 1536 * 2, BG_CAT = BG_QM + (size_t)MT * 512 * 2;
constexpr size_t BG_Q = 0, BG_K = (size_t)MT * 1536 * 2, BG_V = 2 * BG_K;

constexpr int LDS_BYTES = 151552;

struct Params {
    const float* in[21];
    float* out;
    unsigned char* ws;
};
enum { I_XP = 0, I_XS, I_MEM, I_CPOOL, I_CSBK, I_CSBV, I_CMK, I_CMV, I_NMIX, I_WINP, I_WINS, I_POOLW, I_PSCALE, I_NMEM, I_WKV, I_QN, I_KN, I_WOUT, I_NFFN, I_WUP, I_WDOWN };

DI unsigned cvt_pk_bf16(float lo, float hi) { unsigned r; asm("v_cvt_pk_bf16_f32 %0, %1, %2" : "=v"(r) : "v"(lo), "v"(hi)); return r; }
DI int otid() { int t = threadIdx.x; asm volatile("" : "+v"(t)); return t; }
DI float bf_lo(unsigned u) { return __uint_as_float(u << 16); }
DI float bf_hi(unsigned u) { return __uint_as_float(u & 0xffff0000u); }

constexpr int BM = 256, BK = 64, HALF = 128, HTB = HALF * BK * 2, NXCD = 8, WGM = 8;
__host__ __device__ __forceinline__ int lds_byte(int r, int c) { const int st = (r >> 4) * 2 + (c >> 5), rr = r & 15, cc = c & 31, ob = rr * 64 + cc * 2; return st * 1024 + (ob ^ (((ob >> 9) & 1) << 5)); }
__host__ __device__ __forceinline__ void stage_rc(int b, int& R, int& C) { const int st = b / 1024, sb = b % 1024, swz = sb ^ (((sb >> 9) & 1) << 5); R = (st >> 1) * 16 + swz / 64; C = (st & 1) * 32 + (swz % 64) / 2; }
__host__ __device__ __forceinline__ int perm32(int rho) { const int n = rho >> 4, i = rho & 15; return 8 * (i >> 2) + 4 * n + (i & 3); }

struct Unit { int pm, pn, ks; };
enum { MODE_INPOOL = 0, MODE_KV, MODE_POOL, MODE_RESID, MODE_UP, MODE_INSB, MODE_PART };
struct GemmJob {
    const bf16_t* A; const bf16_t* Bt;
    int lda, ldb, K, nM, nN, mode, layer, coff, last;
};

DI bool unit_next(const GemmJob& g, int i, Unit& u) {
    const int G = gridDim.x; const int c = ((int)blockIdx.x - g.coff + G) % G;
    u.ks = 0;
    if (g.mode == MODE_PART) { const int L = i * G + c; if (L >= 256) return false; u.pm = 64 + (L >> 7); u.pn = (L >> 4) & 7; u.ks = L & 15; return true; }
    const int nwg = g.nM * g.nN; const long L = (long)i * G + c; if (L >= nwg) return false;
    int wgid = (int)L; { const int q = nwg / NXCD, r = nwg % NXCD, xcd = wgid % NXCD, off = wgid / NXCD; wgid = (xcd < r ? xcd * (q + 1) : r * (q + 1) + (xcd - r) * q) + off; }
    const int nig = WGM * g.nN, gid = wgid / nig, fm = gid * WGM, gsz = (g.nM - fm) < WGM ? (g.nM - fm) : WGM;
    u.pm = fm + ((wgid % nig) % gsz); u.pn = (wgid % nig) / gsz; return true;
}
DI const char* unit_a(const GemmJob& g, const Unit& u) {
    const char* p = (const char*)g.A + (size_t)u.pm * 256 * g.lda * 2;
    if (g.mode == MODE_POOL) p += (size_t)(u.pn >> 1) * 384 * 2;
    return p + (size_t)u.ks * 512 * 2;
}
DI const char* unit_b(const GemmJob& g, const Unit& u) { return (const char*)g.Bt + (size_t)u.pn * 256 * g.ldb * 2 + (size_t)u.ks * 512 * 2; }

DI float row_rstd(const float* ssp, int row, int fq) {
    const f32x4 a = *(const f32x4*)(ssp + (size_t)row * 32 + fq * 8), b = *(const f32x4*)(ssp + (size_t)row * 32 + fq * 8 + 4);
    float s = (a[0] + a[1]) + (a[2] + a[3]) + (b[0] + b[1]) + (b[2] + b[3]);
    s += __shfl_xor(s, 16); s += __shfl_xor(s, 32);
    return rsqrtf(s * (1.0f / 2048.0f) + EPS);
}

DI void epilogue(const f32x4 (&acc)[2][2][4][2], const GemmJob& g, const Params& P, const Unit& u, int wr, int wc, int fr, int fq) {
    unsigned char* ws = P.ws;
    const float* ssp = nullptr; const float* resid = nullptr; int resid_row0 = 0;
    float* of32 = nullptr; int ldf = 0, colf = 0, f32_row0 = 0;
    bf16_t* obf = nullptr; int ldo = 0, colb = 0; int climit = 256; bool act = false; float* ssp_out = nullptr;
    const int pm = u.pm, pn = u.pn;
    switch (g.mode) {
    case MODE_INPOOL:
        ssp = (const float*)(ws + WS_SSP);
        if (pn < 6) { of32 = (float*)(ws + WS_BIG + BG_U); ldf = 1536; colf = pn * 256; }
        else { obf = (bf16_t*)(ws + WS_BIG + BG_QM); ldo = 512; colb = (pn - 6) * 256; }
        break;
    case MODE_KV:
        ssp = (const float*)(ws + WS_SSPM);
        of32 = (float*)(ws + WS_KV) + (size_t)g.layer * 1024 * 1024; ldf = 1024; colf = pn * 256;
        break;
    case MODE_POOL:
        obf = (bf16_t*)(ws + WS_BIG + BG_CAT); ldo = 2048; colb = (pn >> 1) * 384 + (pn & 1) * 256; climit = (pn & 1) ? 128 : 256;
        break;
    case MODE_RESID:
        if (g.layer == 0) { if (pm < 64) { resid = P.in[I_XP]; resid_row0 = 0; } else { resid = P.in[I_XS]; resid_row0 = MP; } }
        else { resid = P.out + O_Y; resid_row0 = 0; }
        of32 = P.out + O_Y; ldf = 2048; colf = pn * 256;
        if (!g.last) { obf = (bf16_t*)(ws + WS_XB); ldo = 2048; colb = pn * 256; ssp_out = (float*)(ws + WS_SSP); }
        break;
    case MODE_UP:
        ssp = (const float*)(ws + WS_SSP); act = true;
        obf = (bf16_t*)(ws + WS_BIG); ldo = 8192; colb = pn * 256;
        break;
    case MODE_PART:
        of32 = (float*)(ws + WS_PART) + (size_t)u.ks * 512 * 2048; f32_row0 = MP; ldf = 2048; colf = pn * 256;
        break;
    default:
        ssp = (const float*)(ws + WS_SSP);
        if (pn < 6) { obf = (bf16_t*)(ws + WS_BIG + BG_Q); ldo = 1536; colb = pn * 256; }
        else if (pn < 12) { obf = (bf16_t*)(ws + WS_BIG + BG_K); ldo = 1536; colb = (pn - 6) * 256;
            of32 = P.out + (pm < 64 ? O_SKP : O_SKS); f32_row0 = pm < 64 ? 0 : MP; ldf = 1536; colf = colb; }
        else if (pn < 18) { obf = (bf16_t*)(ws + WS_BIG + BG_V); ldo = 1536; colb = (pn - 12) * 256;
            of32 = P.out + (pm < 64 ? O_SVP : O_SVS); f32_row0 = pm < 64 ? 0 : MP; ldf = 1536; colf = colb; }
        else { obf = (bf16_t*)(ws + WS_BIG + BG_QM); ldo = 512; colb = (pn - 18) * 256; }
        break;
    }
    const int row0 = pm * 256 + wr * 64 + fr; const int cl0 = wc * 32 + fq * 8;
#pragma unroll
    for (int ai = 0; ai < 2; ++ai)
#pragma unroll
        for (int m = 0; m < 4; ++m) {
            const int r = row0 + ai * HALF + m * 16;
            float rs = 1.0f;
            if (ssp) rs = row_rstd(ssp, r, fq);
            float ssq = 0.f;
#pragma unroll
            for (int bj = 0; bj < 2; ++bj) {
                const int cl = cl0 + bj * HALF;
                if (cl < climit) {
                    f32x4 v0 = acc[ai][bj][m][0] * rs, v1 = acc[ai][bj][m][1] * rs;
                    if (resid) { const float* rp = resid + (size_t)(r - resid_row0) * 2048 + pn * 256 + cl; v0 += *(const f32x4*)rp; v1 += *(const f32x4*)(rp + 4); }
                    if (act) {
#pragma unroll
                        for (int j = 0; j < 4; ++j) { const float a0 = fmaxf(v0[j], 0.f), a1 = fmaxf(v1[j], 0.f); v0[j] = a0 * a0; v1[j] = a1 * a1; }
                    }
                    if (of32) { float* op = of32 + (size_t)(r - f32_row0) * ldf + colf + cl; *(f32x4*)op = v0; *(f32x4*)(op + 4) = v1; }
                    if (obf) { u32x4 w; w.x = cvt_pk_bf16(v0[0], v0[1]); w.y = cvt_pk_bf16(v0[2], v0[3]); w.z = cvt_pk_bf16(v1[0], v1[1]); w.w = cvt_pk_bf16(v1[2], v1[3]);
                        *(u32x4*)(obf + (size_t)r * ldo + colb + cl) = w; }
                    ssq += (v0[0] * v0[0] + v0[1] * v0[1]) + (v0[2] * v0[2] + v0[3] * v0[3]) + (v1[0] * v1[0] + v1[1] * v1[1]) + (v1[2] * v1[2] + v1[3] * v1[3]);
                }
            }
            if (ssp_out) { ssq += __shfl_xor(ssq, 16); ssq += __shfl_xor(ssq, 32); if (fq == 0) ssp_out[(size_t)r * 32 + pn * 4 + wc] = ssq; }
        }
}

__device__ __forceinline__ void gemm_phase(LAS unsigned char* lds, const GemmJob& g, const Params& P) {
    const int tid = otid(), wid = __builtin_amdgcn_readfirstlane(tid >> 6), lane = tid & 63, wr = wid >> 2, wc = wid & 3, fr = lane & 15, fq = lane >> 4;
    const int K = g.K, nt = K / BK;
    unsigned voffA[2], voffB[2];
#pragma unroll
    for (int i = 0; i < 2; ++i) { int R, C; stage_rc(tid * 16 + i * 8192, R, C); const int Rb = (R & ~31) + perm32(R & 31);
        voffA[i] = (unsigned)(R * g.lda + C) * 2u; voffB[i] = (unsigned)(Rb * g.ldb + C) * 2u; }
    const size_t kstep = (size_t)(BK * 2);
    const size_t hstepA = (size_t)HALF * g.lda * 2, hstepB = (size_t)HALF * g.ldb * 2;
    const unsigned ldsw = (unsigned)wid * 1024u;
    const int aoff = lds_byte(wr * 64 + fr, fq * 8), boff = lds_byte(wc * 32 + fr, fq * 8);
#define PG8_SA(b, h) (((b) * 2 + (h)) * HTB)
#define PG8_SB(b, h) ((4 + (b) * 2 + (h)) * HTB)
#define PG8_STAGE(bufoff, gbase, voff) do { _Pragma("unroll") for (int _i = 0; _i < 2; ++_i) \
        __builtin_amdgcn_global_load_lds((const unsigned*)((const char*)(gbase) + (voff)[_i]), (LAS unsigned*)(lds + (bufoff) + ldsw + _i * 8192), 16, 0, 0); } while (0)
#define PG8_LDA(dst, b, h) do { _Pragma("unroll") for (int m = 0; m < 4; ++m) _Pragma("unroll") for (int k = 0; k < 2; ++k) dst[m][k] = *(const LAS bf16x8*)(lds + PG8_SA(b, h) + aoff + m * 2048 + k * 1024); } while (0)
#define PG8_LDB(dst, b, h) do { _Pragma("unroll") for (int n = 0; n < 2; ++n) _Pragma("unroll") for (int k = 0; k < 2; ++k) dst[n][k] = *(const LAS bf16x8*)(lds + PG8_SB(b, h) + boff + n * 2048 + k * 1024); } while (0)
#define PG8_MMA(ai, bj, At, Bt) do { __builtin_amdgcn_s_setprio(1); _Pragma("unroll") for (int m = 0; m < 4; ++m) _Pragma("unroll") for (int n = 0; n < 2; ++n) _Pragma("unroll") for (int k = 0; k < 2; ++k) \
        acc[ai][bj][m][n] = __builtin_amdgcn_mfma_f32_16x16x32_bf16(Bt[n][k], At[m][k], acc[ai][bj][m][n], 0, 0, 0); __builtin_amdgcn_s_setprio(0); } while (0)
#define PG8_WAIT_V(n) asm volatile("s_waitcnt vmcnt(" #n ")" ::: "memory")
#define PG8_WAIT_L(n) asm volatile("s_waitcnt lgkmcnt(" #n ")" ::: "memory")
#define PG8_BAR __builtin_amdgcn_s_barrier()
#define PG8_SCHED __builtin_amdgcn_sched_barrier(0)
    Unit cur, nxt; int ui = 0;
    if (!unit_next(g, 0, cur)) return;
    f32x4 acc[2][2][4][2];
#pragma unroll
    for (int a = 0; a < 2; ++a)
#pragma unroll
        for (int b = 0; b < 2; ++b)
#pragma unroll
            for (int m = 0; m < 4; ++m)
#pragma unroll
                for (int n = 0; n < 2; ++n) acc[a][b][m][n] = (f32x4){0.f, 0.f, 0.f, 0.f};
    bf16x8 At[4][2], B0[2][2], B1[2][2];
    const char* cA = unit_a(g, cur); const char* cB = unit_b(g, cur);
    PG8_STAGE(PG8_SB(0, 0), cB, voffB); PG8_STAGE(PG8_SA(0, 0), cA, voffA); PG8_STAGE(PG8_SB(0, 1), cB + hstepB, voffB); PG8_STAGE(PG8_SA(0, 1), cA + hstepA, voffA);
    if (wr == 1) PG8_BAR;
    PG8_WAIT_V(4); PG8_BAR;
    PG8_STAGE(PG8_SB(1, 0), cB + kstep, voffB); PG8_STAGE(PG8_SA(1, 0), cA + kstep, voffA); PG8_STAGE(PG8_SB(1, 1), cB + hstepB + kstep, voffB);
    PG8_WAIT_V(6); PG8_BAR;
    for (;;) {
        const bool has_next = unit_next(g, ui + 1, nxt);
        const char* nA = has_next ? unit_a(g, nxt) : cA; const char* nB = has_next ? unit_b(g, nxt) : cB;
        for (int t = 0; t < nt; t += 2) {
            const bool last = (t == nt - 2);
            const char* a1 = cA + (size_t)(t + 1) * kstep;
            const char* a2 = last ? nA : cA + (size_t)(t + 2) * kstep; const char* b2 = last ? nB : cB + (size_t)(t + 2) * kstep;
            const char* a3 = a2 + kstep; const char* b3 = b2 + kstep;
            PG8_LDB(B0, 0, 0); PG8_SCHED; PG8_LDA(At, 0, 0); PG8_STAGE(PG8_SA(1, 1), a1 + hstepA, voffA);
            PG8_WAIT_L(8); PG8_BAR; PG8_WAIT_L(0); PG8_MMA(0, 0, At, B0); PG8_BAR; PG8_SCHED;
            PG8_LDB(B1, 0, 1); PG8_STAGE(PG8_SB(0, 0), b2, voffB);
            PG8_BAR; PG8_WAIT_L(0); PG8_MMA(0, 1, At, B1); PG8_BAR;
            PG8_LDA(At, 0, 1); PG8_STAGE(PG8_SA(0, 0), a2, voffA);
            PG8_BAR; PG8_WAIT_L(0); PG8_MMA(1, 0, At, B0); PG8_BAR; PG8_SCHED;
            PG8_STAGE(PG8_SB(0, 1), b2 + hstepB, voffB);
            PG8_WAIT_V(6); PG8_BAR; PG8_MMA(1, 1, At, B1); PG8_BAR;
            PG8_LDB(B0, 1, 0); PG8_SCHED; PG8_LDA(At, 1, 0); PG8_STAGE(PG8_SA(0, 1), a2 + hstepA, voffA);
            PG8_WAIT_L(8); PG8_BAR; PG8_WAIT_L(0); PG8_MMA(0, 0, At, B0); PG8_BAR; PG8_SCHED;
            PG8_LDB(B1, 1, 1); PG8_STAGE(PG8_SB(1, 0), b3, voffB);
            PG8_BAR; PG8_WAIT_L(0); PG8_MMA(0, 1, At, B1); PG8_BAR;
            PG8_LDA(At, 1, 1); PG8_STAGE(PG8_SA(1, 0), a3, voffA);
            PG8_BAR; PG8_WAIT_L(0); PG8_MMA(1, 0, At, B0); PG8_BAR; PG8_SCHED;
            PG8_STAGE(PG8_SB(1, 1), b3 + hstepB, voffB);
            PG8_WAIT_V(6); PG8_BAR; PG8_MMA(1, 1, At, B1); PG8_BAR;
        }
        epilogue(acc, g, P, cur, wr, wc, fr, fq);
        if (!has_next) break;
#pragma unroll
        for (int a = 0; a < 2; ++a)
#pragma unroll
            for (int b = 0; b < 2; ++b)
#pragma unroll
                for (int m = 0; m < 4; ++m)
#pragma unroll
                    for (int n = 0; n < 2; ++n) acc[a][b][m][n] = (f32x4){0.f, 0.f, 0.f, 0.f};
        cur = nxt; cA = nA; cB = nB; ++ui;
    }
    PG8_WAIT_V(0);
    if (wr == 0) PG8_BAR;
    PG8_BAR;
}

__device__ void convT(LAS unsigned* T, const float* __restrict__ src, bf16_t* __restrict__ dst, int K, int N, const float* kg, const float* ns, int& job) {
    const int tid = otid(), kp = tid >> 4, c4 = (tid & 15) * 4, nb = gridDim.x, bid = blockIdx.x;
    const int nct = (N + 255) / 256, ntiles = (K / 64) * nct;
    const int first = ((bid - job) % nb + nb) % nb;
    for (int ti = first; ti < ntiles; ti += nb) {
        const int kt = ti / nct, ct = ti - kt * nct, k0 = kt * 64, n0 = ct * 256;
        const int nq = min(4, (N - n0) / 64);
        float4 a[4], b[4];
        const float g0 = kg ? kg[k0 + 2 * kp] : 1.f, g1 = kg ? kg[k0 + 2 * kp + 1] : 1.f;
#pragma unroll
        for (int q = 0; q < 4; ++q) if (q < nq) {
            a[q] = *(const float4*)(src + (size_t)(k0 + 2 * kp) * N + n0 + q * 64 + c4);
            b[q] = *(const float4*)(src + (size_t)(k0 + 2 * kp + 1) * N + n0 + q * 64 + c4);
        }
#pragma unroll
        for (int q = 0; q < 4; ++q) if (q < nq) {
            float4 s = make_float4(1.f, 1.f, 1.f, 1.f);
            if (ns) s = *(const float4*)(ns + n0 + q * 64 + c4);
            const int nn = q * 64 + c4;
            T[(nn + 0) * 33 + kp] = cvt_pk_bf16(a[q].x * g0 * s.x, b[q].x * g1 * s.x);
            T[(nn + 1) * 33 + kp] = cvt_pk_bf16(a[q].y * g0 * s.y, b[q].y * g1 * s.y);
            T[(nn + 2) * 33 + kp] = cvt_pk_bf16(a[q].z * g0 * s.z, b[q].z * g1 * s.z);
            T[(nn + 3) * 33 + kp] = cvt_pk_bf16(a[q].w * g0 * s.w, b[q].w * g1 * s.w);
        }
        __syncthreads();
        for (int i = tid; i < nq * 512; i += 512) {
            const int n = i >> 3, ch = i & 7;
            u32x4 w; w.x = T[n * 33 + ch * 4]; w.y = T[n * 33 + ch * 4 + 1]; w.z = T[n * 33 + ch * 4 + 2]; w.w = T[n * 33 + ch * 4 + 3];
            *(u32x4*)(dst + (size_t)(n0 + n) * K + k0 + ch * 8) = w;
        }
        __syncthreads();
    }
    job = (job + ntiles) % nb;
}

__device__ void rows_to_bf16(const float* __restrict__ src, int nrows, bf16_t* __restrict__ dstb, float* __restrict__ ssp) {
    const int tid = otid(), lane = tid & 63, gw = blockIdx.x * 8 + (tid >> 6), nw = gridDim.x * 8;
    for (int r = gw; r < nrows; r += nw) {
        const float* sp = src + (size_t)r * 2048; bf16_t* dp = dstb + (size_t)r * 2048;
        float4 v[8];
#pragma unroll
        for (int i = 0; i < 8; ++i) v[i] = *(const float4*)(sp + (i * 64 + lane) * 4);
        float ss = 0.f;
#pragma unroll
        for (int i = 0; i < 8; ++i) {
            ss += (v[i].x * v[i].x + v[i].y * v[i].y) + (v[i].z * v[i].z + v[i].w * v[i].w);
            u32x2 w; w.x = cvt_pk_bf16(v[i].x, v[i].y); w.y = cvt_pk_bf16(v[i].z, v[i].w);
            *(u32x2*)(dp + (i * 64 + lane) * 4) = w;
        }
        const float t = ss + __shfl_xor(ss, 32);
        if (lane < 32) ssp[(size_t)r * 32 + lane] = t;
    }
}

__device__ void pool_diff(const Params& P) {
    const float* U = (const float*)(P.ws + WS_BIG + BG_U); bf16_t* Dd = (bf16_t*)(P.ws + WS_BIG + BG_D);
    const float* cpool = P.in[I_CPOOL];
    const size_t total = (size_t)MT * 384;
    const int tid = otid();
    for (size_t i = (size_t)blockIdx.x * 512 + tid; i < total; i += (size_t)gridDim.x * 512) {
        const int r = (int)(i / 384), c = (int)(i - (size_t)r * 384) * 4;
        const int g = c / 384, w = 2 << g;
        const bool isp = r < MP;
        const int b = isp ? (r >> 12) : ((r - MP) >> 5), t = isp ? (r & 4095) : ((r - MP) & 31);
        const f32x4 cur = *(const f32x4*)(U + (size_t)r * 1536 + c);
        f32x4 sum = cur;
        for (int j = 1; j < w; ++j) {
            const int tt = t - j;
            if (tt >= 0) sum += *(const f32x4*)(U + (size_t)(r - j) * 1536 + c);
            else if (!isp) sum += *(const f32x4*)(cpool + (size_t)(b * 15 + 15 + tt) * 1536 + c);
        }
        const float cnt = isp ? (float)min(t + 1, w) : (float)w;
        const f32x4 d = sum / cnt - cur;
        u32x2 o; o.x = cvt_pk_bf16(d[0], d[1]); o.y = cvt_pk_bf16(d[2], d[3]);
        *(u32x2*)(Dd + (size_t)r * 1536 + c) = o;
        if (isp) { if (t >= SEQ - 15) *(f32x4*)(P.out + O_PP + (size_t)(b * 15 + t - (SEQ - 15)) * 1536 + c) = cur; }
        else { if (t >= DSEQ - 15) *(f32x4*)(P.out + O_PS + (size_t)(b * 15 + t - (DSEQ - 15)) * 1536 + c) = cur; }
    }
}

__device__ void memkv_finalize(const Params& P) {
    const int tid = otid(), lane = tid & 63, gw = blockIdx.x * 8 + (tid >> 6), nw = gridDim.x * 8;
    const float* KV = (const float*)(P.ws + WS_KV);
    bf16_t* MK = (bf16_t*)(P.ws + WS_MK); bf16_t* MV = (bf16_t*)(P.ws + WS_MV);
    for (int it = gw; it < 2048; it += nw) {
        const int layer = it >> 10, row = it & 1023;
        const float* sp = KV + ((size_t)layer * 1024 + row) * 1024 + lane * 16;
        f32x4 v[4];
#pragma unroll
        for (int i = 0; i < 4; ++i) v[i] = *(const f32x4*)(sp + i * 4);
        float ss = 0.f;
#pragma unroll
        for (int i = 0; i < 4; ++i) ss += (v[i][0] * v[i][0] + v[i][1] * v[i][1]) + (v[i][2] * v[i][2] + v[i][3] * v[i][3]);
        ss += __shfl_xor(ss, 1); ss += __shfl_xor(ss, 2); ss += __shfl_xor(ss, 4);
        const float rs = rsqrtf(ss * (1.0f / 128.0f) + EPS);
        const bool isk = lane < 32;
        const int col = (lane & 31) * 16;
        const float* gn = P.in[I_KN] + layer * 128 + (col & 127);
        float* of = P.out + (isk ? O_MK : O_MV) + ((size_t)layer * 1024 + row) * 512 + col;
        bf16_t* ob = (isk ? MK : MV) + ((size_t)layer * 5120 + row) * 512 + col;
#pragma unroll
        for (int i = 0; i < 4; ++i) {
            f32x4 y = v[i];
            if (isk) { const f32x4 gg = *(const f32x4*)(gn + i * 4); y = y * rs * gg; }
            *(f32x4*)(of + i * 4) = y;
            u32x2 w; w.x = cvt_pk_bf16(y[0], y[1]); w.y = cvt_pk_bf16(y[2], y[3]);
            *(u32x2*)(ob + i * 4) = w;
        }
    }
}

DI bf16x8 tr_frag(LAS unsigned char* base, int off) {
    const s16x4 a = __builtin_amdgcn_ds_read_tr16_b64_v4i16((LAS s16x4*)(base + off));
    const s16x4 b = __builtin_amdgcn_ds_read_tr16_b64_v4i16((LAS s16x4*)(base + off + 8 * 320));
    bf16x8 r; r[0] = a[0]; r[1] = a[1]; r[2] = a[2]; r[3] = a[3]; r[4] = b[0]; r[5] = b[1]; r[6] = b[2]; r[7] = b[3]; return r;
}
DI bf16x8 pack8(const f32x16& p, int s) {
    u32x4 w; w.x = cvt_pk_bf16(p[8 * s + 0], p[8 * s + 1]); w.y = cvt_pk_bf16(p[8 * s + 2], p[8 * s + 3]);
    w.z = cvt_pk_bf16(p[8 * s + 4], p[8 * s + 5]); w.w = cvt_pk_bf16(p[8 * s + 6], p[8 * s + 7]);
    return __builtin_bit_cast(bf16x8, w);
}

__device__ void mem_attn(LAS unsigned char* lds, const Params& P, int layer) {
    const int tid = otid(), wid = __builtin_amdgcn_readfirstlane(tid >> 6), lane = tid & 63, qi = lane & 31, hh = lane >> 5;
    const bf16_t* QM = (const bf16_t*)(P.ws + WS_BIG + BG_QM);
    const bf16_t* MK = (const bf16_t*)(P.ws + WS_MK) + (size_t)layer * 20 * 256 * 512;
    const bf16_t* MV = (const bf16_t*)(P.ws + WS_MV) + (size_t)layer * 20 * 256 * 512;
    bf16_t* CAT = (bf16_t*)(P.ws + WS_BIG + BG_CAT);
    const float* qg = P.in[I_QN] + layer * 128;
    LAS unsigned char* Kl = lds; LAS unsigned char* Vl = lds + 256 * 272;
    for (int it = blockIdx.x; it < 320; it += gridDim.x) {
        int bb, hd, rowbase; bool active;
        if (it < 256) { const int b = it >> 6, h = (it >> 4) & 3, ch = it & 15; bb = b; hd = h; rowbase = b * SEQ + ch * 256 + wid * 32; active = true; }
        else { const int j = it - 256, b = j >> 2, h = j & 3; bb = 4 + b; hd = h; rowbase = MP + b * DSEQ; active = (wid == 0); }
        const bf16_t* ks = MK + (size_t)bb * 256 * 512 + hd * 128; const bf16_t* vs = MV + (size_t)bb * 256 * 512 + hd * 128;
#pragma unroll
        for (int i = 0; i < 8; ++i) {
            const int c = i * 512 + tid, row = c >> 4, ch = c & 15;
            const u32x4 kv = *(const u32x4*)(ks + (size_t)row * 512 + ch * 8);
            const u32x4 vv = *(const u32x4*)(vs + (size_t)row * 512 + ch * 8);
            *(LAS u32x4*)(Kl + row * 272 + ch * 16) = kv;
            *(LAS u32x4*)(Vl + row * 320 + ch * 16) = vv;
        }
        __syncthreads();
        if (active) {
            bf16x8 qf[8]; float ss = 0.f;
            const bf16_t* qp = QM + (size_t)(rowbase + qi) * 512 + hd * 128 + hh * 8;
#pragma unroll
            for (int s = 0; s < 8; ++s) {
                const u32x4 raw = *(const u32x4*)(qp + s * 16);
                const f32x4 g0 = *(const f32x4*)(qg + s * 16 + hh * 8), g1 = *(const f32x4*)(qg + s * 16 + hh * 8 + 4);
                float q0 = bf_lo(raw.x), q1 = bf_hi(raw.x), q2 = bf_lo(raw.y), q3 = bf_hi(raw.y), q4 = bf_lo(raw.z), q5 = bf_hi(raw.z), q6 = bf_lo(raw.w), q7 = bf_hi(raw.w);
                ss += (q0 * q0 + q1 * q1) + (q2 * q2 + q3 * q3) + (q4 * q4 + q5 * q5) + (q6 * q6 + q7 * q7);
                u32x4 w; w.x = cvt_pk_bf16(q0 * g0[0], q1 * g0[1]); w.y = cvt_pk_bf16(q2 * g0[2], q3 * g0[3]); w.z = cvt_pk_bf16(q4 * g1[0], q5 * g1[1]); w.w = cvt_pk_bf16(q6 * g1[2], q7 * g1[3]);
                qf[s] = __builtin_bit_cast(bf16x8, w);
            }
            ss += __shfl_xor(ss, 32);
            const float scale = rsqrtf(ss * (1.0f / 128.0f) + EPS) * 0.08838834764831845f * 1.4426950408889634f;
            float m_run = -1e30f, l_run = 0.f;
            f32x16 O[4];
#pragma unroll
            for (int d = 0; d < 4; ++d)
#pragma unroll
                for (int i = 0; i < 16; ++i) O[d][i] = 0.f;
            LAS unsigned char* vtb = Vl + (4 * hh + ((lane & 15) >> 2)) * 320 + (16 * ((lane >> 4) & 1) + 4 * (lane & 3)) * 2;
            for (int kt = 0; kt < 8; ++kt) {
                f32x16 S;
#pragma unroll
                for (int i = 0; i < 16; ++i) S[i] = 0.f;
#pragma unroll
                for (int s = 0; s < 8; ++s) {
                    const bf16x8 kf = *(const LAS bf16x8*)(Kl + (kt * 32 + qi) * 272 + (16 * s + 8 * hh) * 2);
                    S = __builtin_amdgcn_mfma_f32_32x32x16_bf16(kf, qf[s], S, 0, 0, 0);
                }
                float tmax = -1e30f;
#pragma unroll
                for (int i = 0; i < 16; ++i) { S[i] *= scale; tmax = fmaxf(tmax, S[i]); }
                tmax = fmaxf(tmax, __shfl_xor(tmax, 32));
                const float m_new = fmaxf(m_run, tmax), alpha = exp2f(m_run - m_new); m_run = m_new;
                float lsum = 0.f;
#pragma unroll
                for (int i = 0; i < 16; ++i) { S[i] = exp2f(S[i] - m_new); lsum += S[i]; }
                l_run = l_run * alpha + lsum;
#pragma unroll
                for (int d = 0; d < 4; ++d)
#pragma unroll
                    for (int i = 0; i < 16; ++i) O[d][i] *= alpha;
                const bf16x8 p0 = pack8(S, 0), p1 = pack8(S, 1);
#pragma unroll
                for (int d = 0; d < 4; ++d) {
                    const bf16x8 v0 = tr_frag(vtb, (kt * 32) * 320 + d * 64), v1 = tr_frag(vtb, (kt * 32 + 16) * 320 + d * 64);
                    O[d] = __builtin_amdgcn_mfma_f32_32x32x16_bf16(v0, p0, O[d], 0, 0, 0);
                    O[d] = __builtin_amdgcn_mfma_f32_32x32x16_bf16(v1, p1, O[d], 0, 0, 0);
                }
            }
            l_run += __shfl_xor(l_run, 32);
            const float inv = 1.0f / l_run;
            bf16_t* op = CAT + (size_t)(rowbase + qi) * 2048 + 1536 + hd * 128 + 4 * hh;
#pragma unroll
            for (int d = 0; d < 4; ++d)
#pragma unroll
                for (int gq = 0; gq < 4; ++gq) {
                    u32x2 w; w.x = cvt_pk_bf16(O[d][4 * gq] * inv, O[d][4 * gq + 1] * inv); w.y = cvt_pk_bf16(O[d][4 * gq + 2] * inv, O[d][4 * gq + 3] * inv);
                    *(u32x2*)(op + 32 * d + 8 * gq) = w;
                }
        }
        __syncthreads();
    }
}

DI bf16x8 ld_frag_f32(const float* p) {
    const f32x4 a = *(const f32x4*)p, b = *(const f32x4*)(p + 4);
    u32x4 w; w.x = cvt_pk_bf16(a[0], a[1]); w.y = cvt_pk_bf16(a[2], a[3]); w.z = cvt_pk_bf16(b[0], b[1]); w.w = cvt_pk_bf16(b[2], b[3]);
    return __builtin_bit_cast(bf16x8, w);
}

__device__ void sb_item(LAS unsigned char* vl, const Params& P, int lane, bool sample, int b, int h, int qt) {
    const int qi = lane & 31, hh = lane >> 5;
    const bf16_t* Qb = (const bf16_t*)(P.ws + WS_BIG + BG_Q); const bf16_t* Kb = (const bf16_t*)(P.ws + WS_BIG + BG_K); const bf16_t* Vb = (const bf16_t*)(P.ws + WS_BIG + BG_V);
    bf16_t* CAT = (bf16_t*)(P.ws + WS_BIG + BG_CAT);
    const int rowbase = sample ? (MP + b * DSEQ) : (b * SEQ + qt * 32);
    const int kt_hi = sample ? (PAST / 32) : qt;
    bf16x8 qf[8];
    { const bf16_t* qp = Qb + (size_t)(rowbase + qi) * 1536 + h * 128 + hh * 8;
#pragma unroll
      for (int s = 0; s < 8; ++s) qf[s] = *(const bf16x8*)(qp + s * 16); }
    f32x16 O[4];
#pragma unroll
    for (int d = 0; d < 4; ++d)
#pragma unroll
        for (int i = 0; i < 16; ++i) O[d][i] = 0.f;
    float C = 0.f;
    LAS unsigned char* vtb = vl + (4 * hh + ((lane & 15) >> 2)) * 320 + (16 * ((lane >> 4) & 1) + 4 * (lane & 3)) * 2;
    for (int kt = kt_hi; kt >= 0; --kt) {
        const bool diag = (kt == kt_hi);
        const bool from_cache = sample && !diag;
        f32x16 S;
#pragma unroll
        for (int i = 0; i < 16; ++i) S[i] = 0.f;
        if (from_cache) {
            const float* kp = P.in[I_CSBK] + ((size_t)(b * PAST + kt * 32 + qi)) * 1536 + h * 128 + hh * 8;
            const float* vp = P.in[I_CSBV] + ((size_t)(b * PAST + kt * 32)) * 1536 + h * 128;
#pragma unroll
            for (int i = 0; i < 8; ++i) { const int c = i * 64 + lane, row = c >> 4, ch = c & 15;
                const bf16x8 v = ld_frag_f32(vp + (size_t)row * 1536 + ch * 8);
                *(LAS bf16x8*)(vl + row * 320 + ch * 16) = v; }
#pragma unroll
            for (int s = 0; s < 8; ++s) { const bf16x8 kf = ld_frag_f32(kp + s * 16); S = __builtin_amdgcn_mfma_f32_32x32x16_bf16(kf, qf[s], S, 0, 0, 0); }
        } else {
            const int krow = sample ? (MP + b * DSEQ) : (b * SEQ + kt * 32);
            const bf16_t* kp = Kb + (size_t)(krow + qi) * 1536 + h * 128 + hh * 8;
            const bf16_t* vp = Vb + (size_t)krow * 1536 + h * 128;
#pragma unroll
            for (int i = 0; i < 8; ++i) { const int c = i * 64 + lane, row = c >> 4, ch = c & 15;
                const bf16x8 v = *(const bf16x8*)(vp + (size_t)row * 1536 + ch * 8);
                *(LAS bf16x8*)(vl + row * 320 + ch * 16) = v; }
#pragma unroll
            for (int s = 0; s < 8; ++s) { const bf16x8 kf = *(const bf16x8*)(kp + s * 16); S = __builtin_amdgcn_mfma_f32_32x32x16_bf16(kf, qf[s], S, 0, 0, 0); }
        }
        float lf[16], ls[16];
#pragma unroll
        for (int i = 0; i < 16; ++i) {
            const float z = S[i] * 0.08838834764831845f;
            const int j = (i & 3) + 8 * (i >> 2) + 4 * hh;
            const bool valid = !diag || (j < qi);
            const float sp = fmaxf(z, 0.f) + __logf(1.0f + __expf(-fabsf(z)));
            lf[i] = valid ? -sp : 0.f;
            ls[i] = valid ? (z - sp) : -1e30f;
        }
        float G[4], Gp[4], T[4];
#pragma unroll
        for (int gq = 0; gq < 4; ++gq) { G[gq] = (lf[4 * gq] + lf[4 * gq + 1]) + (lf[4 * gq + 2] + lf[4 * gq + 3]); Gp[gq] = __shfl_xor(G[gq], 32); }
        float run = 0.f;
#pragma unroll
        for (int gq = 3; gq >= 0; --gq) { T[gq] = run + (hh == 0 ? Gp[gq] : 0.f); run += G[gq] + Gp[gq]; }
#pragma unroll
        for (int gq = 0; gq < 4; ++gq) {
            float af = T[gq] + C;
#pragma unroll
            for (int r = 3; r >= 0; --r) { const int i = 4 * gq + r; S[i] = __expf(ls[i] + af); af += lf[i]; }
        }
        C += run;
        const bf16x8 p0 = pack8(S, 0), p1 = pack8(S, 1);
#pragma unroll
        for (int d = 0; d < 4; ++d) {
            const bf16x8 v0 = tr_frag(vtb, d * 64), v1 = tr_frag(vtb, 16 * 320 + d * 64);
            O[d] = __builtin_amdgcn_mfma_f32_32x32x16_bf16(v0, p0, O[d], 0, 0, 0);
            O[d] = __builtin_amdgcn_mfma_f32_32x32x16_bf16(v1, p1, O[d], 0, 0, 0);
        }
        if (__builtin_amdgcn_ballot_w64(C > -110.0f) == 0ull) break;
    }
    bf16_t* op = CAT + (size_t)(rowbase + qi) * 2048 + h * 128 + 4 * hh;
#pragma unroll
    for (int d = 0; d < 4; ++d)
#pragma unroll
        for (int gq = 0; gq < 4; ++gq) {
            u32x2 w; w.x = cvt_pk_bf16(O[d][4 * gq], O[d][4 * gq + 1]); w.y = cvt_pk_bf16(O[d][4 * gq + 2], O[d][4 * gq + 3]);
            *(u32x2*)(op + 32 * d + 8 * gq) = w;
        }
}

__device__ void sb_attn(LAS unsigned char* lds, const Params& P) {
    const int tid = otid(), wid = __builtin_amdgcn_readfirstlane(tid >> 6), lane = tid & 63;
    LAS unsigned char* vl = lds + wid * 10240;
    const int gw = blockIdx.x * 8 + wid, nw = gridDim.x * 8;
#pragma unroll 1
    for (int k = 0; k < 1 + (4 * NSBH * 128 + nw - 1) / nw; ++k) {
        bool sample; int b, h, qt;
        if (k == 0) { if (wid != 0 || (int)blockIdx.x >= 16 * NSBH) continue; sample = true; b = blockIdx.x / NSBH; h = blockIdx.x % NSBH; qt = 0; }
        else { const int j = (k - 1) * nw + gw; if (j >= 4 * NSBH * 128) continue; const int bh = j >> 7; sample = false; b = bh / NSBH; h = bh % NSBH; qt = j & 127; }
        sb_item(vl, P, lane, sample, b, h, qt);
    }
}

__device__ void down_fixup(const Params& P, bool last) {
    const int tid = otid(), lane = tid & 63, gw = blockIdx.x * 8 + (tid >> 6), nw = gridDim.x * 8;
    const float* part = (const float*)(P.ws + WS_PART);
    for (int r = gw; r < MS; r += nw) {
        float* xp = P.out + O_Y + (size_t)(MP + r) * 2048;
        f32x4 v[8];
#pragma unroll
        for (int i = 0; i < 8; ++i) v[i] = *(const f32x4*)(xp + (i * 64 + lane) * 4);
#pragma unroll 1
        for (int ks = 0; ks < 16; ++ks) {
            const float* pp = part + ((size_t)ks * 512 + r) * 2048;
#pragma unroll
            for (int i = 0; i < 8; ++i) v[i] += *(const f32x4*)(pp + (i * 64 + lane) * 4);
        }
        float ss = 0.f;
#pragma unroll
        for (int i = 0; i < 8; ++i) {
            *(f32x4*)(xp + (i * 64 + lane) * 4) = v[i];
            ss += (v[i][0] * v[i][0] + v[i][1] * v[i][1]) + (v[i][2] * v[i][2] + v[i][3] * v[i][3]);
            if (!last) { u32x2 w; w.x = cvt_pk_bf16(v[i][0], v[i][1]); w.y = cvt_pk_bf16(v[i][2], v[i][3]);
                *(u32x2*)((bf16_t*)(P.ws + WS_XB) + (size_t)(MP + r) * 2048 + (i * 64 + lane) * 4) = w; }
        }
        const float t = ss + __shfl_xor(ss, 32);
        if (!last && lane < 32) ((float*)(P.ws + WS_SSP))[(size_t)(MP + r) * 32 + lane] = t;
    }
}

__device__ void prologue(LAS unsigned char* lds, const Params& P) {
    unsigned char* ws = P.ws;
    int job = 0; LAS unsigned* T = (LAS unsigned*)lds;
#pragma unroll 1
    for (int wi = 0; wi < 16; ++wi) {
        const float* src; bf16_t* dst; int K, N; const float* kg = nullptr; const float* ns = nullptr;
        if (wi == 0) { src = P.in[I_WINP]; dst = (bf16_t*)(ws + WS_WINP); K = 2048; N = 2048; kg = P.in[I_NMIX]; }
        else if (wi < 3) { const int l = wi - 1; src = P.in[I_WKV] + (size_t)l * 2048 * 1024; dst = (bf16_t*)(ws + WS_WKV) + (size_t)l * 1024 * 2048; K = 2048; N = 1024; kg = P.in[I_NMEM] + l * 2048; }
        else if (wi < 7) { const int gq = wi - 3; src = P.in[I_POOLW] + (size_t)gq * 384 * 384; dst = (bf16_t*)(ws + WS_POOLW) + (size_t)gq * 512 * 384; K = 384; N = 384; ns = P.in[I_PSCALE] + gq * 384; }
        else if (wi < 9) { const int l = wi - 7; src = P.in[I_WOUT] + (size_t)l * 2048 * 2048; dst = (bf16_t*)(ws + WS_WOUT) + (size_t)l * 2048 * 2048; K = 2048; N = 2048; }
        else if (wi < 11) { const int l = wi - 9; src = P.in[I_WUP] + (size_t)l * 2048 * 8192; dst = (bf16_t*)(ws + WS_WUP) + (size_t)l * 8192 * 2048; K = 2048; N = 8192; kg = P.in[I_NFFN] + l * 2048; }
        else if (wi < 13) { const int l = wi - 11; src = P.in[I_WDOWN] + (size_t)l * 8192 * 2048; dst = (bf16_t*)(ws + WS_WDOWN) + (size_t)l * 2048 * 8192; K = 8192; N = 2048; }
        else if (wi == 13) { src = P.in[I_WINS]; dst = (bf16_t*)(ws + WS_WINS); K = 2048; N = 5120; kg = P.in[I_NMIX] + 2048; }
        else continue;
        convT(T, src, dst, K, N, kg, ns, job);
    }
#pragma unroll 1
    for (int ri = 0; ri < 3; ++ri) {
        const float* src = ri == 0 ? P.in[I_XP] : (ri == 1 ? P.in[I_XS] : P.in[I_MEM]);
        const int nrows = ri == 0 ? MP : (ri == 1 ? MS : NMT);
        bf16_t* db = ri == 0 ? (bf16_t*)(ws + WS_XB) : (ri == 1 ? (bf16_t*)(ws + WS_XB) + (size_t)MP * 2048 : (bf16_t*)(ws + WS_MB));
        float* sp = ri == 0 ? (float*)(ws + WS_SSP) : (ri == 1 ? (float*)(ws + WS_SSP) + (size_t)MP * 32 : (float*)(ws + WS_SSPM));
        rows_to_bf16(src, nrows, db, sp);
    }
#pragma unroll 1
    for (int l = 0; l < 2; ++l) {
        const size_t n4 = (size_t)16 * 256 * 512 / 4;
        const int tid = otid();
        for (size_t i = (size_t)blockIdx.x * 512 + tid; i < 2 * n4; i += (size_t)gridDim.x * 512) {
            const bool isv = i >= n4; const size_t e = (isv ? i - n4 : i) * 4;
            const f32x4 v = *(const f32x4*)(P.in[isv ? I_CMV : I_CMK] + (size_t)l * 16 * 256 * 512 + e);
            u32x2 w; w.x = cvt_pk_bf16(v[0], v[1]); w.y = cvt_pk_bf16(v[2], v[3]);
            *(u32x2*)((bf16_t*)(ws + (isv ? WS_MV : WS_MK)) + ((size_t)l * 20 + 4) * 256 * 512 + e) = w;
        }
    }
}

DI int step_ngemm(int step) { return step == 1 ? 3 : ((step == 6 || step == 12) ? 2 : ((step == 0 || step == 2 || step == 7 || step == 9 || step == 13) ? 0 : 1)); }
DI GemmJob step_job(const Params& P, int step, int gi) {
    unsigned char* ws = P.ws; GemmJob g{};
    g.lda = 2048; g.ldb = 2048; g.K = 2048; g.nM = 66; g.nN = 8;
    const int layer = step >= 8 ? 1 : 0;
    if (step == 1) {
        if (gi == 0) { g.A = (const bf16_t*)(ws + WS_XB); g.Bt = (const bf16_t*)(ws + WS_WINP); g.mode = MODE_INPOOL; }
        else { const int l = gi - 1; g.A = (const bf16_t*)(ws + WS_MB); g.Bt = (const bf16_t*)(ws + WS_WKV) + (size_t)l * 1024 * 2048; g.nM = 4; g.nN = 4; g.mode = MODE_KV; g.layer = l; g.coff = 16 + 16 * l; }
    } else if (step == 3) { g.A = (const bf16_t*)(ws + WS_BIG + BG_D); g.Bt = (const bf16_t*)(ws + WS_POOLW); g.lda = 1536; g.ldb = 384; g.K = 384; g.mode = MODE_POOL; }
    else if (step == 4 || step == 10) { g.A = (const bf16_t*)(ws + WS_BIG + BG_CAT); g.Bt = (const bf16_t*)(ws + WS_WOUT) + (size_t)layer * 2048 * 2048; g.mode = MODE_RESID; g.layer = layer; }
    else if (step == 5 || step == 11) { g.A = (const bf16_t*)(ws + WS_XB); g.Bt = (const bf16_t*)(ws + WS_WUP) + (size_t)layer * 8192 * 2048; g.nN = 32; g.mode = MODE_UP; }
    else if (step == 6 || step == 12) { g.A = (const bf16_t*)(ws + WS_BIG); g.Bt = (const bf16_t*)(ws + WS_WDOWN) + (size_t)layer * 2048 * 8192; g.lda = 8192; g.ldb = 8192;
        if (gi == 0) { g.K = 8192; g.nM = 64; g.mode = MODE_RESID; g.layer = 1; g.last = layer; }
        else { g.K = 512; g.mode = MODE_PART; } }
    else { g.A = (const bf16_t*)(ws + WS_XB); g.Bt = (const bf16_t*)(ws + WS_WINS); g.nN = 20; g.mode = MODE_INSB; }
    return g;
}

__global__ void __launch_bounds__(512, 2) fwd_megakernel(Params P) {
    extern __shared__ __attribute__((aligned(16))) unsigned char smem[];
    LAS unsigned char* lds = (LAS unsigned char*)smem;
    cg::grid_group grid = cg::this_grid();
#pragma unroll 1
    for (int step = 0; step < 14; ++step) {
        if (step == 0) prologue(lds, P);
        if (step == 2) { pool_diff(P); memkv_finalize(P); }
        if (step == 7 || step == 13) down_fixup(P, step == 13);
        if (step == 9) sb_attn(lds, P);
        const int ng = step_ngemm(step);
#pragma unroll 1
        for (int gi = 0; gi < ng; ++gi) { const GemmJob g = step_job(P, step, gi); gemm_phase(lds, g, P); }
        if (step == 3 || step == 9) { __syncthreads(); mem_attn(lds, P, step == 9 ? 1 : 0); }
        if (step < 13) grid.sync();
    }
}

extern "C" void kernel_launch(void* const* d_in, const int* in_sizes, int n_in, void* d_out, int out_size, void* d_ws, size_t ws_size, hipStream_t stream) {
    static int state = 0;
    if (state == 0) {
        state = 1;
        if (n_in != 21 || ws_size < WS_END) { fprintf(stderr, "kernel_launch: need 21 inputs and %zu bytes of workspace (got %d, %zu)\n", (size_t)WS_END, n_in, ws_size); state = -1; }
        if (hipFuncSetAttribute((const void*)fwd_megakernel, hipFuncAttributeMaxDynamicSharedMemorySize, LDS_BYTES) != hipSuccess) { fprintf(stderr, "kernel_launch: hipFuncSetAttribute failed\n"); state = -1; }
        int per_cu = 0;
        if (hipOccupancyMaxActiveBlocksPerMultiprocessor(&per_cu, (const void*)fwd_megakernel, 512, LDS_BYTES) != hipSuccess || per_cu < 1) fprintf(stderr, "kernel_launch: occupancy query reports %d blocks per CU\n", per_cu);
        (void)hipGetLastError();
    }
    if (state < 0) return;
    Params p{};
    for (int i = 0; i < 21; ++i) p.in[i] = (const float*)d_in[i];
    p.out = (float*)d_out; p.ws = (unsigned char*)d_ws;
    void* args[] = {&p};
    hipError_t e = hipLaunchCooperativeKernel((const void*)fwd_megakernel, dim3(256), dim3(512), args, LDS_BYTES, stream);
    if (e != hipSuccess) fprintf(stderr, "cooperative launch failed: %s\n", hipGetErrorString(e));
}
```

```cpp
#include <hip/hip_runtime.h>
#include <hip/hip_cooperative_groups.h>
#include <cstdio>
namespace cg = cooperative_groups;

#define LAS __attribute__((address_space(3)))
#define DI __device__ __forceinline__
typedef unsigned short bf16_t;
typedef short bf16x8 __attribute__((ext_vector_type(8)));
typedef short s16x4 __attribute__((ext_vector_type(4)));
typedef float f32x4 __attribute__((ext_vector_type(4)));
typedef float f32x16 __attribute__((ext_vector_type(16)));
typedef unsigned u32x4 __attribute__((ext_vector_type(4)));
typedef unsigned u32x2 __attribute__((ext_vector_type(2)));

constexpr int DM = 2048, MP = 16384, MS = 512, MT = 16896, NMT = 1024, DTOK = 1536, DMEM = 512, DFF = 8192;
constexpr int SEQ = 4096, DSEQ = 32, PAST = 1024, NSBH = 12, HD = 128;
constexpr float EPS = 1e-6f;
constexpr size_t O_Y = 0, O_PP = 34603008, O_PS = O_PP + 92160, O_SKP = O_PS + 368640, O_SVP = O_SKP + 25165824,
                 O_SKS = O_SVP + 25165824, O_SVS = O_SKS + 786432, O_MK = O_SVS + 786432, O_MV = O_MK + 1048576;
constexpr size_t WS_WINP = 0;
constexpr size_t WS_WINS = WS_WINP + (size_t)2048 * 2048 * 2;
constexpr size_t WS_POOLW = WS_WINS + (size_t)5120 * 2048 * 2;
constexpr size_t WS_WKV = WS_POOLW + (size_t)4 * 512 * 384 * 2;
constexpr size_t WS_WOUT = WS_WKV + (size_t)2 * 1024 * 2048 * 2;
constexpr size_t WS_WUP = WS_WOUT + (size_t)2 * 2048 * 2048 * 2;
constexpr size_t WS_WDOWN = WS_WUP + (size_t)2 * 8192 * 2048 * 2;
constexpr size_t WS_XB = WS_WDOWN + (size_t)2 * 2048 * 8192 * 2;
constexpr size_t WS_MB = WS_XB + (size_t)MT * 2048 * 2;
constexpr size_t WS_SSP = WS_MB + (size_t)NMT * 2048 * 2;
constexpr size_t WS_SSPM = WS_SSP + (size_t)MT * 32 * 4;
constexpr size_t WS_KV = WS_SSPM + (size_t)NMT * 32 * 4;
constexpr size_t WS_MK = WS_KV + (size_t)2 * 1024 * 1024 * 4;
constexpr size_t WS_MV = WS_MK + (size_t)2 * 20 * 256 * 512 * 2;
constexpr size_t WS_BIG = WS_MV + (size_t)2 * 20 * 256 * 512 * 2;
constexpr size_t WS_PART = WS_BIG + (size_t)MT * 8192 * 2;
constexpr size_t WS_END = WS_PART + (size_t)16 * 512 * 2048 * 4;
constexpr size_t BG_U = 0, BG_D = (size_t)MT * 1536 * 4, BG_QM = BG_D + (size_t)MT * 1536 * 2, BG_CAT = BG_QM + (size_t)MT * 512 * 2;
constexpr size_t BG_Q = 0, BG_K = (size_t)MT * 1536 * 2, BG_V = 2 * BG_K;

constexpr int LDS_BYTES = 151552;

struct Params {
    const float* in[21];
    float* out;
    unsigned char* ws;
};
enum { I_XP = 0, I_XS, I_MEM, I_CPOOL, I_CSBK, I_CSBV, I_CMK, I_CMV, I_NMIX, I_WINP, I_WINS, I_POOLW, I_PSCALE, I_NMEM, I_WKV, I_QN, I_KN, I_WOUT, I_NFFN, I_WUP, I_WDOWN };

DI unsigned cvt_pk_bf16(float lo, float hi) { unsigned r; asm("v_cvt_pk_bf16_f32 %0, %1, %2" : "=v"(r) : "v"(lo), "v"(hi)); return r; }
DI int otid() { int t = threadIdx.x; asm volatile("" : "+v"(t)); return t; }
DI float bf_lo(unsigned u) { return __uint_as_float(u << 16); }
DI float bf_hi(unsigned u) { return __uint_as_float(u & 0xffff0000u); }

constexpr int BM = 256, BK = 64, HALF = 128, HTB = HALF * BK * 2, NXCD = 8, WGM = 8;
__host__ __device__ __forceinline__ int lds_byte(int r, int c) { const int st = (r >> 4) * 2 + (c >> 5), rr = r & 15, cc = c & 31, ob = rr * 64 + cc * 2; return st * 1024 + (ob ^ (((ob >> 9) & 1) << 5)); }
__host__ __device__ __forceinline__ void stage_rc(int b, int& R, int& C) { const int st = b / 1024, sb = b % 1024, swz = sb ^ (((sb >> 9) & 1) << 5); R = (st >> 1) * 16 + swz / 64; C = (st & 1) * 32 + (swz % 64) / 2; }
__host__ __device__ __forceinline__ int perm32(int rho) { const int n = rho >> 4, i = rho & 15; return 8 * (i >> 2) + 4 * n + (i & 3); }

struct Unit { int pm, pn, ks; };
enum { MODE_INPOOL = 0, MODE_KV, MODE_POOL, MODE_RESID, MODE_UP, MODE_INSB, MODE_PART };
struct GemmJob {
    const bf16_t* A; const bf16_t* Bt;
    int lda, ldb, K, nM, nN, mode, layer, coff, last;
};

DI bool unit_next(const GemmJob& g, int i, Unit& u) {
    const int G = gridDim.x; const int c = ((int)blockIdx.x - g.coff + G) % G;
    u.ks = 0;
    if (g.mode == MODE_PART) { const int L = i * G + c; if (L >= 256) return false; u.pm = 64 + (L >> 7); u.pn = (L >> 4) & 7; u.ks = L & 15; return true; }
    const int nwg = g.nM * g.nN; const long L = (long)i * G + c; if (L >= nwg) return false;
    int wgid = (int)L; { const int q = nwg / NXCD, r = nwg % NXCD, xcd = wgid % NXCD, off = wgid / NXCD; wgid = (xcd < r ? xcd * (q + 1) : r * (q + 1) + (xcd - r) * q) + off; }
    const int nig = WGM * g.nN, gid = wgid / nig, fm = gid * WGM, gsz = (g.nM - fm) < WGM ? (g.nM - fm) : WGM;
    u.pm = fm + ((wgid % nig) % gsz); u.pn = (wgid % nig) / gsz; return true;
}
DI const char* unit_a(const GemmJob& g, const Unit& u) {
    const char* p = (const char*)g.A + (size_t)u.pm * 256 * g.lda * 2;
    if (g.mode == MODE_POOL) p += (size_t)(u.pn >> 1) * 384 * 2;
    return p + (size_t)u.ks * 512 * 2;
}
DI const char* unit_b(const GemmJob& g, const Unit& u) { return (const char*)g.Bt + (size_t)u.pn * 256 * g.ldb * 2 + (size_t)u.ks * 512 * 2; }

DI float row_rstd(const float* ssp, int row, int fq) {
    const f32x4 a = *(const f32x4*)(ssp + (size_t)row * 32 + fq * 8), b = *(const f32x4*)(ssp + (size_t)row * 32 + fq * 8 + 4);
    float s = (a[0] + a[1]) + (a[2] + a[3]) + (b[0] + b[1]) + (b[2] + b[3]);
    s += __shfl_xor(s, 16); s += __shfl_xor(s, 32);
    return rsqrtf(s * (1.0f / 2048.0f) + EPS);
}

DI void epilogue(const f32x4 (&acc)[2][2][4][2], const GemmJob& g, const Params& P, const Unit& u, int wr, int wc, int fr, int fq) {
    unsigned char* ws = P.ws;
    const float* ssp = nullptr;
    float* of32 = nullptr; int ldf = 0, colf = 0, f32_row0 = 0;
    bf16_t* obf = nullptr; int ldo = 0, colb = 0; int climit = 256; bool act = false; float* ssp_out = nullptr;
    const int pm = u.pm, pn = u.pn;
    switch (g.mode) {
    case MODE_INPOOL:
        ssp = (const float*)(ws + WS_SSP);
        if (pn < 6) { of32 = (float*)(ws + WS_BIG + BG_U); ldf = 1536; colf = pn * 256; }
        else { obf = (bf16_t*)(ws + WS_BIG + BG_QM); ldo = 512; colb = (pn - 6) * 256; }
        break;
    case MODE_KV:
        ssp = (const float*)(ws + WS_SSPM);
        of32 = (float*)(ws + WS_KV) + (size_t)g.layer * 1024 * 1024; ldf = 1024; colf = pn * 256;
        break;
    case MODE_POOL:
        obf = (bf16_t*)(ws + WS_BIG + BG_CAT); ldo = 2048; colb = (pn >> 1) * 384 + (pn & 1) * 256; climit = (pn & 1) ? 128 : 256;
        break;
    case MODE_RESID:
        of32 = P.out + O_Y; ldf = 2048; colf = pn * 256;
        if (!g.last) { obf = (bf16_t*)(ws + WS_XB); ldo = 2048; colb = pn * 256; ssp_out = (float*)(ws + WS_SSP); }
        break;
    case MODE_UP:
        ssp = (const float*)(ws + WS_SSP); act = true;
        obf = (bf16_t*)(ws + WS_BIG); ldo = 8192; colb = pn * 256;
        break;
    case MODE_PART:
        of32 = (float*)(ws + WS_PART) + (size_t)u.ks * 512 * 2048; f32_row0 = MP; ldf = 2048; colf = pn * 256;
        break;
    default:
        ssp = (const float*)(ws + WS_SSP);
        if (pn < 6) { obf = (bf16_t*)(ws + WS_BIG + BG_Q); ldo = 1536; colb = pn * 256; }
        else if (pn < 12) { obf = (bf16_t*)(ws + WS_BIG + BG_K); ldo = 1536; colb = (pn - 6) * 256;
            of32 = P.out + (pm < 64 ? O_SKP : O_SKS); f32_row0 = pm < 64 ? 0 : MP; ldf = 1536; colf = colb; }
        else if (pn < 18) { obf = (bf16_t*)(ws + WS_BIG + BG_V); ldo = 1536; colb = (pn - 12) * 256;
            of32 = P.out + (pm < 64 ? O_SVP : O_SVS); f32_row0 = pm < 64 ? 0 : MP; ldf = 1536; colf = colb; }
        else { obf = (bf16_t*)(ws + WS_BIG + BG_QM); ldo = 512; colb = (pn - 18) * 256; }
        break;
    }
    const int row0 = pm * 256 + wr * 64 + fr; const int cl0 = wc * 32 + fq * 8;
    float rsv[8];
    if (ssp) {
        f32x4 pa[8], pb[8];
#pragma unroll
        for (int k = 0; k < 8; ++k) { const float* sp = ssp + (size_t)(row0 + (k >> 2) * HALF + (k & 3) * 16) * 32 + fq * 8; pa[k] = *(const f32x4*)sp; pb[k] = *(const f32x4*)(sp + 4); }
#pragma unroll
        for (int k = 0; k < 8; ++k) { float t = (pa[k][0] + pa[k][1]) + (pa[k][2] + pa[k][3]) + (pb[k][0] + pb[k][1]) + (pb[k][2] + pb[k][3]);
            t += __shfl_xor(t, 16); t += __shfl_xor(t, 32); rsv[k] = rsqrtf(t * (1.0f / 2048.0f) + EPS); }
    } else {
#pragma unroll
        for (int k = 0; k < 8; ++k) rsv[k] = 1.0f;
    }
#pragma unroll
    for (int ai = 0; ai < 2; ++ai)
#pragma unroll
        for (int m = 0; m < 4; ++m) {
            const int r = row0 + ai * HALF + m * 16;
            const float rs = rsv[ai * 4 + m];
            float ssq = 0.f;
#pragma unroll
            for (int bj = 0; bj < 2; ++bj) {
                const int cl = cl0 + bj * HALF;
                if (cl < climit) {
                    f32x4 v0 = acc[ai][bj][m][0] * rs, v1 = acc[ai][bj][m][1] * rs;
                    if (act) {
#pragma unroll
                        for (int j = 0; j < 4; ++j) { const float a0 = fmaxf(v0[j], 0.f), a1 = fmaxf(v1[j], 0.f); v0[j] = a0 * a0; v1[j] = a1 * a1; }
                    }
                    if (of32) { float* op = of32 + (size_t)(r - f32_row0) * ldf + colf + cl; *(f32x4*)op = v0; *(f32x4*)(op + 4) = v1; }
                    if (obf) { u32x4 w; w.x = cvt_pk_bf16(v0[0], v0[1]); w.y = cvt_pk_bf16(v0[2], v0[3]); w.z = cvt_pk_bf16(v1[0], v1[1]); w.w = cvt_pk_bf16(v1[2], v1[3]);
                        *(u32x4*)(obf + (size_t)r * ldo + colb + cl) = w; }
                    ssq += (v0[0] * v0[0] + v0[1] * v0[1]) + (v0[2] * v0[2] + v0[3] * v0[3]) + (v1[0] * v1[0] + v1[1] * v1[1]) + (v1[2] * v1[2] + v1[3] * v1[3]);
                }
            }
            if (ssp_out) { ssq += __shfl_xor(ssq, 16); ssq += __shfl_xor(ssq, 32); if (fq == 0) ssp_out[(size_t)r * 32 + pn * 4 + wc] = ssq; }
        }
}

DI void acc_init(f32x4 (&acc)[2][2][4][2], const GemmJob& g, const Params& P, const Unit& u, int wr, int wc, int fr, int fq) {
    if (g.mode == MODE_RESID) {
        const float* resid; int resid_row0 = 0;
        if (g.layer == 0) { if (u.pm < 64) { resid = P.in[I_XP]; } else { resid = P.in[I_XS]; resid_row0 = MP; } }
        else resid = P.out + O_Y;
        const float* rp0 = resid + (size_t)(u.pm * 256 + wr * 64 + fr - resid_row0) * 2048 + u.pn * 256 + wc * 32 + fq * 8;
#pragma unroll
        for (int ai = 0; ai < 2; ++ai)
#pragma unroll
            for (int m = 0; m < 4; ++m)
#pragma unroll
                for (int bj = 0; bj < 2; ++bj) { const float* rp = rp0 + (size_t)(ai * HALF + m * 16) * 2048 + bj * HALF;
                    acc[ai][bj][m][0] = *(const f32x4*)rp; acc[ai][bj][m][1] = *(const f32x4*)(rp + 4); }
    } else {
#pragma unroll
        for (int a = 0; a < 2; ++a)
#pragma unroll
            for (int b = 0; b < 2; ++b)
#pragma unroll
                for (int m = 0; m < 4; ++m)
#pragma unroll
                    for (int n = 0; n < 2; ++n) acc[a][b][m][n] = (f32x4){0.f, 0.f, 0.f, 0.f};
    }
}

__device__ __forceinline__ void gemm_phase(LAS unsigned char* lds, const GemmJob& g, const Params& P) {
    const int tid = otid(), wid = __builtin_amdgcn_readfirstlane(tid >> 6), lane = tid & 63, wr = wid >> 2, wc = wid & 3, fr = lane & 15, fq = lane >> 4;
    const int K = g.K, nt = K / BK;
    unsigned voffA[2], voffB[2];
#pragma unroll
    for (int i = 0; i < 2; ++i) { int R, C; stage_rc(tid * 16 + i * 8192, R, C); const int Rb = (R & ~31) + perm32(R & 31);
        voffA[i] = (unsigned)(R * g.lda + C) * 2u; voffB[i] = (unsigned)(Rb * g.ldb + C) * 2u; }
    const size_t kstep = (size_t)(BK * 2);
    const size_t hstepA = (size_t)HALF * g.lda * 2, hstepB = (size_t)HALF * g.ldb * 2;
    const unsigned ldsw = (unsigned)wid * 1024u;
    const int aoff = lds_byte(wr * 64 + fr, fq * 8), boff = lds_byte(wc * 32 + fr, fq * 8);
#define PG8_SA(b, h) (((b) * 2 + (h)) * HTB)
#define PG8_SB(b, h) ((4 + (b) * 2 + (h)) * HTB)
#define PG8_STAGE(bufoff, gbase, voff) do { _Pragma("unroll") for (int _i = 0; _i < 2; ++_i) \
        __builtin_amdgcn_global_load_lds((const unsigned*)((const char*)(gbase) + (voff)[_i]), (LAS unsigned*)(lds + (bufoff) + ldsw + _i * 8192), 16, 0, 0); } while (0)
#define PG8_LDA(dst, b, h) do { _Pragma("unroll") for (int m = 0; m < 4; ++m) _Pragma("unroll") for (int k = 0; k < 2; ++k) dst[m][k] = *(const LAS bf16x8*)(lds + PG8_SA(b, h) + aoff + m * 2048 + k * 1024); } while (0)
#define PG8_LDB(dst, b, h) do { _Pragma("unroll") for (int n = 0; n < 2; ++n) _Pragma("unroll") for (int k = 0; k < 2; ++k) dst[n][k] = *(const LAS bf16x8*)(lds + PG8_SB(b, h) + boff + n * 2048 + k * 1024); } while (0)
#define PG8_MMA(ai, bj, At, Bt) do { __builtin_amdgcn_s_setprio(1); _Pragma("unroll") for (int m = 0; m < 4; ++m) _Pragma("unroll") for (int n = 0; n < 2; ++n) _Pragma("unroll") for (int k = 0; k < 2; ++k) \
        acc[ai][bj][m][n] = __builtin_amdgcn_mfma_f32_16x16x32_bf16(Bt[n][k], At[m][k], acc[ai][bj][m][n], 0, 0, 0); __builtin_amdgcn_s_setprio(0); } while (0)
#define PG8_WAIT_V(n) asm volatile("s_waitcnt vmcnt(" #n ")" ::: "memory")
#define PG8_WAIT_L(n) asm volatile("s_waitcnt lgkmcnt(" #n ")" ::: "memory")
#define PG8_BAR __builtin_amdgcn_s_barrier()
#define PG8_SCHED __builtin_amdgcn_sched_barrier(0)
    Unit cur, nxt; int ui = 0;
    if (!unit_next(g, 0, cur)) return;
    f32x4 acc[2][2][4][2];
    acc_init(acc, g, P, cur, wr, wc, fr, fq);
    bf16x8 At[4][2], B0[2][2], B1[2][2];
    const char* cA = unit_a(g, cur); const char* cB = unit_b(g, cur);
    PG8_STAGE(PG8_SB(0, 0), cB, voffB); PG8_STAGE(PG8_SA(0, 0), cA, voffA); PG8_STAGE(PG8_SB(0, 1), cB + hstepB, voffB); PG8_STAGE(PG8_SA(0, 1), cA + hstepA, voffA);
    if (wr == 1) PG8_BAR;
    PG8_WAIT_V(4); PG8_BAR;
    PG8_STAGE(PG8_SB(1, 0), cB + kstep, voffB); PG8_STAGE(PG8_SA(1, 0), cA + kstep, voffA); PG8_STAGE(PG8_SB(1, 1), cB + hstepB + kstep, voffB);
    PG8_WAIT_V(6); PG8_BAR;
    for (;;) {
        const bool has_next = unit_next(g, ui + 1, nxt);
        const char* nA = has_next ? unit_a(g, nxt) : cA; const char* nB = has_next ? unit_b(g, nxt) : cB;
        for (int t = 0; t < nt; t += 2) {
            const bool last = (t == nt - 2);
            const char* a1 = cA + (size_t)(t + 1) * kstep;
            const char* a2 = last ? nA : cA + (size_t)(t + 2) * kstep; const char* b2 = last ? nB : cB + (size_t)(t + 2) * kstep;
            const char* a3 = a2 + kstep; const char* b3 = b2 + kstep;
            PG8_LDB(B0, 0, 0); PG8_SCHED; PG8_LDA(At, 0, 0); PG8_STAGE(PG8_SA(1, 1), a1 + hstepA, voffA);
            PG8_WAIT_L(8); PG8_BAR; PG8_WAIT_L(0); PG8_MMA(0, 0, At, B0); PG8_BAR; PG8_SCHED;
            PG8_LDB(B1, 0, 1); PG8_STAGE(PG8_SB(0, 0), b2, voffB);
            PG8_BAR; PG8_WAIT_L(0); PG8_MMA(0, 1, At, B1); PG8_BAR;
            PG8_LDA(At, 0, 1); PG8_STAGE(PG8_SA(0, 0), a2, voffA);
            PG8_BAR; PG8_WAIT_L(0); PG8_MMA(1, 0, At, B0); PG8_BAR; PG8_SCHED;
            PG8_STAGE(PG8_SB(0, 1), b2 + hstepB, voffB);
            PG8_WAIT_V(6); PG8_BAR; PG8_MMA(1, 1, At, B1); PG8_BAR;
            PG8_LDB(B0, 1, 0); PG8_SCHED; PG8_LDA(At, 1, 0); PG8_STAGE(PG8_SA(0, 1), a2 + hstepA, voffA);
            PG8_WAIT_L(8); PG8_BAR; PG8_WAIT_L(0); PG8_MMA(0, 0, At, B0); PG8_BAR; PG8_SCHED;
            PG8_LDB(B1, 1, 1); PG8_STAGE(PG8_SB(1, 0), b3, voffB);
            PG8_BAR; PG8_WAIT_L(0); PG8_MMA(0, 1, At, B1); PG8_BAR;
            PG8_LDA(At, 1, 1); PG8_STAGE(PG8_SA(1, 0), a3, voffA);
            PG8_BAR; PG8_WAIT_L(0); PG8_MMA(1, 0, At, B0); PG8_BAR; PG8_SCHED;
            PG8_STAGE(PG8_SB(1, 1), b3 + hstepB, voffB);
            PG8_WAIT_V(6); PG8_BAR; PG8_MMA(1, 1, At, B1); PG8_BAR;
        }
        epilogue(acc, g, P, cur, wr, wc, fr, fq);
        if (!has_next) break;
        acc_init(acc, g, P, nxt, wr, wc, fr, fq);
        cur = nxt; cA = nA; cB = nB; ++ui;
    }
    PG8_WAIT_V(0);
    if (wr == 0) PG8_BAR;
    PG8_BAR;
}

__device__ void convT(LAS unsigned* T, const float* __restrict__ src, bf16_t* __restrict__ dst, int K, int N, const float* kg, const float* ns, int& job) {
    const int tid = otid(), kp = tid >> 4, c4 = (tid & 15) * 4, nb = gridDim.x, bid = blockIdx.x;
    const int nct = (N + 255) / 256, ntiles = (K / 64) * nct;
    const int first = ((bid - job) % nb + nb) % nb;
    for (int ti = first; ti < ntiles; ti += nb) {
        const int kt = ti / nct, ct = ti - kt * nct, k0 = kt * 64, n0 = ct * 256;
        const int nq = min(4, (N - n0) / 64);
        float4 a[4], b[4];
        const float g0 = kg ? kg[k0 + 2 * kp] : 1.f, g1 = kg ? kg[k0 + 2 * kp + 1] : 1.f;
#pragma unroll
        for (int q = 0; q < 4; ++q) if (q < nq) {
            a[q] = *(const float4*)(src + (size_t)(k0 + 2 * kp) * N + n0 + q * 64 + c4);
            b[q] = *(const float4*)(src + (size_t)(k0 + 2 * kp + 1) * N + n0 + q * 64 + c4);
        }
#pragma unroll
        for (int q = 0; q < 4; ++q) if (q < nq) {
            float4 s = make_float4(1.f, 1.f, 1.f, 1.f);
            if (ns) s = *(const float4*)(ns + n0 + q * 64 + c4);
            const int nn = q * 64 + c4;
            T[(nn + 0) * 33 + kp] = cvt_pk_bf16(a[q].x * g0 * s.x, b[q].x * g1 * s.x);
            T[(nn + 1) * 33 + kp] = cvt_pk_bf16(a[q].y * g0 * s.y, b[q].y * g1 * s.y);
            T[(nn + 2) * 33 + kp] = cvt_pk_bf16(a[q].z * g0 * s.z, b[q].z * g1 * s.z);
            T[(nn + 3) * 33 + kp] = cvt_pk_bf16(a[q].w * g0 * s.w, b[q].w * g1 * s.w);
        }
        __syncthreads();
        for (int i = tid; i < nq * 512; i += 512) {
            const int n = i >> 3, ch = i & 7;
            u32x4 w; w.x = T[n * 33 + ch * 4]; w.y = T[n * 33 + ch * 4 + 1]; w.z = T[n * 33 + ch * 4 + 2]; w.w = T[n * 33 + ch * 4 + 3];
            *(u32x4*)(dst + (size_t)(n0 + n) * K + k0 + ch * 8) = w;
        }
        __syncthreads();
    }
    job = (job + ntiles) % nb;
}

__device__ void rows_to_bf16(const float* __restrict__ src, int nrows, bf16_t* __restrict__ dstb, float* __restrict__ ssp) {
    const int tid = otid(), lane = tid & 63, gw = blockIdx.x * 8 + (tid >> 6), nw = gridDim.x * 8;
    for (int r = gw; r < nrows; r += nw) {
        const float* sp = src + (size_t)r * 2048; bf16_t* dp = dstb + (size_t)r * 2048;
        float4 v[8];
#pragma unroll
        for (int i = 0; i < 8; ++i) v[i] = *(const float4*)(sp + (i * 64 + lane) * 4);
        float ss = 0.f;
#pragma unroll
        for (int i = 0; i < 8; ++i) {
            ss += (v[i].x * v[i].x + v[i].y * v[i].y) + (v[i].z * v[i].z + v[i].w * v[i].w);
            u32x2 w; w.x = cvt_pk_bf16(v[i].x, v[i].y); w.y = cvt_pk_bf16(v[i].z, v[i].w);
            *(u32x2*)(dp + (i * 64 + lane) * 4) = w;
        }
        const float t = ss + __shfl_xor(ss, 32);
        if (lane < 32) ssp[(size_t)r * 32 + lane] = t;
    }
}

__device__ void pool_diff(const Params& P) {
    const float* U = (const float*)(P.ws + WS_BIG + BG_U); bf16_t* Dd = (bf16_t*)(P.ws + WS_BIG + BG_D);
    const float* cpool = P.in[I_CPOOL];
    const size_t total = (size_t)MT * 384;
    const int tid = otid();
    for (size_t i = (size_t)blockIdx.x * 512 + tid; i < total; i += (size_t)gridDim.x * 512) {
        const int r = (int)(i / 384), c = (int)(i - (size_t)r * 384) * 4;
        const int g = c / 384, w = 2 << g;
        const bool isp = r < MP;
        const int b = isp ? (r >> 12) : ((r - MP) >> 5), t = isp ? (r & 4095) : ((r - MP) & 31);
        const f32x4 cur = *(const f32x4*)(U + (size_t)r * 1536 + c);
        f32x4 sum = cur;
        for (int j = 1; j < w; ++j) {
            const int tt = t - j;
            if (tt >= 0) sum += *(const f32x4*)(U + (size_t)(r - j) * 1536 + c);
            else if (!isp) sum += *(const f32x4*)(cpool + (size_t)(b * 15 + 15 + tt) * 1536 + c);
        }
        const float cnt = isp ? (float)min(t + 1, w) : (float)w;
        const f32x4 d = sum / cnt - cur;
        u32x2 o; o.x = cvt_pk_bf16(d[0], d[1]); o.y = cvt_pk_bf16(d[2], d[3]);
        *(u32x2*)(Dd + (size_t)r * 1536 + c) = o;
        if (isp) { if (t >= SEQ - 15) *(f32x4*)(P.out + O_PP + (size_t)(b * 15 + t - (SEQ - 15)) * 1536 + c) = cur; }
        else { if (t >= DSEQ - 15) *(f32x4*)(P.out + O_PS + (size_t)(b * 15 + t - (DSEQ - 15)) * 1536 + c) = cur; }
    }
}

__device__ void memkv_finalize(const Params& P) {
    const int tid = otid(), lane = tid & 63, gw = blockIdx.x * 8 + (tid >> 6), nw = gridDim.x * 8;
    const float* KV = (const float*)(P.ws + WS_KV);
    bf16_t* MK = (bf16_t*)(P.ws + WS_MK); bf16_t* MV = (bf16_t*)(P.ws + WS_MV);
    for (int it = gw; it < 2048; it += nw) {
        const int layer = it >> 10, row = it & 1023;
        const float* sp = KV + ((size_t)layer * 1024 + row) * 1024 + lane * 16;
        f32x4 v[4];
#pragma unroll
        for (int i = 0; i < 4; ++i) v[i] = *(const f32x4*)(sp + i * 4);
        float ss = 0.f;
#pragma unroll
        for (int i = 0; i < 4; ++i) ss += (v[i][0] * v[i][0] + v[i][1] * v[i][1]) + (v[i][2] * v[i][2] + v[i][3] * v[i][3]);
        ss += __shfl_xor(ss, 1); ss += __shfl_xor(ss, 2); ss += __shfl_xor(ss, 4);
        const float rs = rsqrtf(ss * (1.0f / 128.0f) + EPS);
        const bool isk = lane < 32;
        const int col = (lane & 31) * 16;
        const float* gn = P.in[I_KN] + layer * 128 + (col & 127);
        float* of = P.out + (isk ? O_MK : O_MV) + ((size_t)layer * 1024 + row) * 512 + col;
        bf16_t* ob = (isk ? MK : MV) + ((size_t)layer * 5120 + row) * 512 + col;
#pragma unroll
        for (int i = 0; i < 4; ++i) {
            f32x4 y = v[i];
            if (isk) { const f32x4 gg = *(const f32x4*)(gn + i * 4); y = y * rs * gg; }
            *(f32x4*)(of + i * 4) = y;
            u32x2 w; w.x = cvt_pk_bf16(y[0], y[1]); w.y = cvt_pk_bf16(y[2], y[3]);
            *(u32x2*)(ob + i * 4) = w;
        }
    }
}

DI bf16x8 tr_frag(LAS unsigned char* base, int off) {
    const s16x4 a = __builtin_amdgcn_ds_read_tr16_b64_v4i16((LAS s16x4*)(base + off));
    const s16x4 b = __builtin_amdgcn_ds_read_tr16_b64_v4i16((LAS s16x4*)(base + off + 8 * 320));
    bf16x8 r; r[0] = a[0]; r[1] = a[1]; r[2] = a[2]; r[3] = a[3]; r[4] = b[0]; r[5] = b[1]; r[6] = b[2]; r[7] = b[3]; return r;
}
DI bf16x8 pack8(const f32x16& p, int s) {
    u32x4 w; w.x = cvt_pk_bf16(p[8 * s + 0], p[8 * s + 1]); w.y = cvt_pk_bf16(p[8 * s + 2], p[8 * s + 3]);
    w.z = cvt_pk_bf16(p[8 * s + 4], p[8 * s + 5]); w.w = cvt_pk_bf16(p[8 * s + 6], p[8 * s + 7]);
    return __builtin_bit_cast(bf16x8, w);
}

__device__ void mem_attn(LAS unsigned char* lds, const Params& P, int layer) {
    const int tid = otid(), wid = __builtin_amdgcn_readfirstlane(tid >> 6), lane = tid & 63, qi = lane & 31, hh = lane >> 5;
    const bf16_t* QM = (const bf16_t*)(P.ws + WS_BIG + BG_QM);
    const bf16_t* MK = (const bf16_t*)(P.ws + WS_MK) + (size_t)layer * 20 * 256 * 512;
    const bf16_t* MV = (const bf16_t*)(P.ws + WS_MV) + (size_t)layer * 20 * 256 * 512;
    bf16_t* CAT = (bf16_t*)(P.ws + WS_BIG + BG_CAT);
    const float* qg = P.in[I_QN] + layer * 128;
    LAS unsigned char* Kl = lds; LAS unsigned char* Vl = lds + 256 * 272;
    for (int it = blockIdx.x; it < 320; it += gridDim.x) {
        int bb, hd, rowbase; bool active;
        if (it < 256) { const int b = it >> 6, h = (it >> 4) & 3, ch = it & 15; bb = b; hd = h; rowbase = b * SEQ + ch * 256 + wid * 32; active = true; }
        else { const int j = it - 256, b = j >> 2, h = j & 3; bb = 4 + b; hd = h; rowbase = MP + b * DSEQ; active = (wid == 0); }
        const bf16_t* ks = MK + (size_t)bb * 256 * 512 + hd * 128; const bf16_t* vs = MV + (size_t)bb * 256 * 512 + hd * 128;
#pragma unroll
        for (int i = 0; i < 8; ++i) {
            const int c = i * 512 + tid, row = c >> 4, ch = c & 15;
            const u32x4 kv = *(const u32x4*)(ks + (size_t)row * 512 + ch * 8);
            const u32x4 vv = *(const u32x4*)(vs + (size_t)row * 512 + ch * 8);
            *(LAS u32x4*)(Kl + row * 272 + ch * 16) = kv;
            *(LAS u32x4*)(Vl + row * 320 + ch * 16) = vv;
        }
        __syncthreads();
        if (active) {
            bf16x8 qf[8]; float ss = 0.f;
            const bf16_t* qp = QM + (size_t)(rowbase + qi) * 512 + hd * 128 + hh * 8;
#pragma unroll
            for (int s = 0; s < 8; ++s) {
                const u32x4 raw = *(const u32x4*)(qp + s * 16);
                const f32x4 g0 = *(const f32x4*)(qg + s * 16 + hh * 8), g1 = *(const f32x4*)(qg + s * 16 + hh * 8 + 4);
                float q0 = bf_lo(raw.x), q1 = bf_hi(raw.x), q2 = bf_lo(raw.y), q3 = bf_hi(raw.y), q4 = bf_lo(raw.z), q5 = bf_hi(raw.z), q6 = bf_lo(raw.w), q7 = bf_hi(raw.w);
                ss += (q0 * q0 + q1 * q1) + (q2 * q2 + q3 * q3) + (q4 * q4 + q5 * q5) + (q6 * q6 + q7 * q7);
                u32x4 w; w.x = cvt_pk_bf16(q0 * g0[0], q1 * g0[1]); w.y = cvt_pk_bf16(q2 * g0[2], q3 * g0[3]); w.z = cvt_pk_bf16(q4 * g1[0], q5 * g1[1]); w.w = cvt_pk_bf16(q6 * g1[2], q7 * g1[3]);
                qf[s] = __builtin_bit_cast(bf16x8, w);
            }
            ss += __shfl_xor(ss, 32);
            const float scale = rsqrtf(ss * (1.0f / 128.0f) + EPS) * 0.08838834764831845f * 1.4426950408889634f;
            float m_run = -1e30f, l_run = 0.f;
            f32x16 O[4];
#pragma unroll
            for (int d = 0; d < 4; ++d)
#pragma unroll
                for (int i = 0; i < 16; ++i) O[d][i] = 0.f;
            LAS unsigned char* vtb = Vl + (4 * hh + ((lane & 15) >> 2)) * 320 + (16 * ((lane >> 4) & 1) + 4 * (lane & 3)) * 2;
            for (int kt = 0; kt < 8; ++kt) {
                f32x16 S;
#pragma unroll
                for (int i = 0; i < 16; ++i) S[i] = 0.f;
#pragma unroll
                for (int s = 0; s < 8; ++s) {
                    const bf16x8 kf = *(const LAS bf16x8*)(Kl + (kt * 32 + qi) * 272 + (16 * s + 8 * hh) * 2);
                    S = __builtin_amdgcn_mfma_f32_32x32x16_bf16(kf, qf[s], S, 0, 0, 0);
                }
                float tmax = -1e30f;
#pragma unroll
                for (int i = 0; i < 16; ++i) { S[i] *= scale; tmax = fmaxf(tmax, S[i]); }
                tmax = fmaxf(tmax, __shfl_xor(tmax, 32));
                const float m_new = fmaxf(m_run, tmax), alpha = exp2f(m_run - m_new); m_run = m_new;
                float lsum = 0.f;
#pragma unroll
                for (int i = 0; i < 16; ++i) { S[i] = exp2f(S[i] - m_new); lsum += S[i]; }
                l_run = l_run * alpha + lsum;
#pragma unroll
                for (int d = 0; d < 4; ++d)
#pragma unroll
                    for (int i = 0; i < 16; ++i) O[d][i] *= alpha;
                const bf16x8 p0 = pack8(S, 0), p1 = pack8(S, 1);
#pragma unroll
                for (int d = 0; d < 4; ++d) {
                    const bf16x8 v0 = tr_frag(vtb, (kt * 32) * 320 + d * 64), v1 = tr_frag(vtb, (kt * 32 + 16) * 320 + d * 64);
                    O[d] = __builtin_amdgcn_mfma_f32_32x32x16_bf16(v0, p0, O[d], 0, 0, 0);
                    O[d] = __builtin_amdgcn_mfma_f32_32x32x16_bf16(v1, p1, O[d], 0, 0, 0);
                }
            }
            l_run += __shfl_xor(l_run, 32);
            const float inv = 1.0f / l_run;
            bf16_t* op = CAT + (size_t)(rowbase + qi) * 2048 + 1536 + hd * 128 + 4 * hh;
#pragma unroll
            for (int d = 0; d < 4; ++d)
#pragma unroll
                for (int gq = 0; gq < 4; ++gq) {
                    u32x2 w; w.x = cvt_pk_bf16(O[d][4 * gq] * inv, O[d][4 * gq + 1] * inv); w.y = cvt_pk_bf16(O[d][4 * gq + 2] * inv, O[d][4 * gq + 3] * inv);
                    *(u32x2*)(op + 32 * d + 8 * gq) = w;
                }
        }
        __syncthreads();
    }
}

DI bf16x8 ld_frag_f32(const float* p) {
    const f32x4 a = *(const f32x4*)p, b = *(const f32x4*)(p + 4);
    u32x4 w; w.x = cvt_pk_bf16(a[0], a[1]); w.y = cvt_pk_bf16(a[2], a[3]); w.z = cvt_pk_bf16(b[0], b[1]); w.w = cvt_pk_bf16(b[2], b[3]);
    return __builtin_bit_cast(bf16x8, w);
}

__device__ void sb_item(LAS unsigned char* vl, const Params& P, int lane, bool sample, int b, int h, int qt) {
    const int qi = lane & 31, hh = lane >> 5;
    const bf16_t* Qb = (const bf16_t*)(P.ws + WS_BIG + BG_Q); const bf16_t* Kb = (const bf16_t*)(P.ws + WS_BIG + BG_K); const bf16_t* Vb = (const bf16_t*)(P.ws + WS_BIG + BG_V);
    bf16_t* CAT = (bf16_t*)(P.ws + WS_BIG + BG_CAT);
    const int rowbase = sample ? (MP + b * DSEQ) : (b * SEQ + qt * 32);
    const int kt_hi = sample ? (PAST / 32) : qt;
    bf16x8 qf[8];
    { const bf16_t* qp = Qb + (size_t)(rowbase + qi) * 1536 + h * 128 + hh * 8;
#pragma unroll
      for (int s = 0; s < 8; ++s) qf[s] = *(const bf16x8*)(qp + s * 16); }
    f32x16 O[4];
#pragma unroll
    for (int d = 0; d < 4; ++d)
#pragma unroll
        for (int i = 0; i < 16; ++i) O[d][i] = 0.f;
    float C = 0.f;
    LAS unsigned char* vtb = vl + (4 * hh + ((lane & 15) >> 2)) * 320 + (16 * ((lane >> 4) & 1) + 4 * (lane & 3)) * 2;
    for (int kt = kt_hi; kt >= 0; --kt) {
        const bool diag = (kt == kt_hi);
        const bool from_cache = sample && !diag;
        f32x16 S;
#pragma unroll
        for (int i = 0; i < 16; ++i) S[i] = 0.f;
        if (from_cache) {
            const float* kp = P.in[I_CSBK] + ((size_t)(b * PAST + kt * 32 + qi)) * 1536 + h * 128 + hh * 8;
            const float* vp = P.in[I_CSBV] + ((size_t)(b * PAST + kt * 32)) * 1536 + h * 128;
#pragma unroll
            for (int i = 0; i < 8; ++i) { const int c = i * 64 + lane, row = c >> 4, ch = c & 15;
                const bf16x8 v = ld_frag_f32(vp + (size_t)row * 1536 + ch * 8);
                *(LAS bf16x8*)(vl + row * 320 + ch * 16) = v; }
#pragma unroll
            for (int s = 0; s < 8; ++s) { const bf16x8 kf = ld_frag_f32(kp + s * 16); S = __builtin_amdgcn_mfma_f32_32x32x16_bf16(kf, qf[s], S, 0, 0, 0); }
        } else {
            const int krow = sample ? (MP + b * DSEQ) : (b * SEQ + kt * 32);
            const bf16_t* kp = Kb + (size_t)(krow + qi) * 1536 + h * 128 + hh * 8;
            const bf16_t* vp = Vb + (size_t)krow * 1536 + h * 128;
#pragma unroll
            for (int i = 0; i < 8; ++i) { const int c = i * 64 + lane, row = c >> 4, ch = c & 15;
                const bf16x8 v = *(const bf16x8*)(vp + (size_t)row * 1536 + ch * 8);
                *(LAS bf16x8*)(vl + row * 320 + ch * 16) = v; }
#pragma unroll
            for (int s = 0; s < 8; ++s) { const bf16x8 kf = *(const bf16x8*)(kp + s * 16); S = __builtin_amdgcn_mfma_f32_32x32x16_bf16(kf, qf[s], S, 0, 0, 0); }
        }
        float lf[16], ls[16];
#pragma unroll
        for (int i = 0; i < 16; ++i) {
            const float z = S[i] * 0.08838834764831845f;
            const int j = (i & 3) + 8 * (i >> 2) + 4 * hh;
            const bool valid = !diag || (j < qi);
            const float sp = fmaxf(z, 0.f) + __logf(1.0f + __expf(-fabsf(z)));
            lf[i] = valid ? -sp : 0.f;
            ls[i] = valid ? (z - sp) : -1e30f;
        }
        float G[4], Gp[4], T[4];
#pragma unroll
        for (int gq = 0; gq < 4; ++gq) { G[gq] = (lf[4 * gq] + lf[4 * gq + 1]) + (lf[4 * gq + 2] + lf[4 * gq + 3]); Gp[gq] = __shfl_xor(G[gq], 32); }
        float run = 0.f;
#pragma unroll
        for (int gq = 3; gq >= 0; --gq) { T[gq] = run + (hh == 0 ? Gp[gq] : 0.f); run += G[gq] + Gp[gq]; }
#pragma unroll
        for (int gq = 0; gq < 4; ++gq) {
            float af = T[gq] + C;
#pragma unroll
            for (int r = 3; r >= 0; --r) { const int i = 4 * gq + r; S[i] = __expf(ls[i] + af); af += lf[i]; }
        }
        C += run;
        const bf16x8 p0 = pack8(S, 0), p1 = pack8(S, 1);
#pragma unroll
        for (int d = 0; d < 4; ++d) {
            const bf16x8 v0 = tr_frag(vtb, d * 64), v1 = tr_frag(vtb, 16 * 320 + d * 64);
            O[d] = __builtin_amdgcn_mfma_f32_32x32x16_bf16(v0, p0, O[d], 0, 0, 0);
            O[d] = __builtin_amdgcn_mfma_f32_32x32x16_bf16(v1, p1, O[d], 0, 0, 0);
        }
        if (__builtin_amdgcn_ballot_w64(C > -110.0f) == 0ull) break;
    }
    bf16_t* op = CAT + (size_t)(rowbase + qi) * 2048 + h * 128 + 4 * hh;
#pragma unroll
    for (int d = 0; d < 4; ++d)
#pragma unroll
        for (int gq = 0; gq < 4; ++gq) {
            u32x2 w; w.x = cvt_pk_bf16(O[d][4 * gq], O[d][4 * gq + 1]); w.y = cvt_pk_bf16(O[d][4 * gq + 2], O[d][4 * gq + 3]);
            *(u32x2*)(op + 32 * d + 8 * gq) = w;
        }
}

__device__ void sb_attn(LAS unsigned char* lds, const Params& P) {
    const int tid = otid(), wid = __builtin_amdgcn_readfirstlane(tid >> 6), lane = tid & 63;
    LAS unsigned char* vl = lds + wid * 10240;
    const int gw = blockIdx.x * 8 + wid, nw = gridDim.x * 8;
#pragma unroll 1
    for (int k = 0; k < 1 + (4 * NSBH * 128 + nw - 1) / nw; ++k) {
        bool sample; int b, h, qt;
        if (k == 0) { if (wid != 0 || (int)blockIdx.x >= 16 * NSBH) continue; sample = true; b = blockIdx.x / NSBH; h = blockIdx.x % NSBH; qt = 0; }
        else { const int j = (k - 1) * nw + gw; if (j >= 4 * NSBH * 128) continue; const int bh = j >> 7; sample = false; b = bh / NSBH; h = bh % NSBH; qt = j & 127; }
        sb_item(vl, P, lane, sample, b, h, qt);
    }
}

__device__ void down_fixup(const Params& P, bool last) {
    const int tid = otid(), lane = tid & 63, gw = blockIdx.x * 8 + (tid >> 6), nw = gridDim.x * 8;
    const float* part = (const float*)(P.ws + WS_PART);
    for (int r = gw; r < MS; r += nw) {
        float* xp = P.out + O_Y + (size_t)(MP + r) * 2048;
        f32x4 v[8];
#pragma unroll
        for (int i = 0; i < 8; ++i) v[i] = *(const f32x4*)(xp + (i * 64 + lane) * 4);
#pragma unroll 1
        for (int ks = 0; ks < 16; ++ks) {
            const float* pp = part + ((size_t)ks * 512 + r) * 2048;
#pragma unroll
            for (int i = 0; i < 8; ++i) v[i] += *(const f32x4*)(pp + (i * 64 + lane) * 4);
        }
        float ss = 0.f;
#pragma unroll
        for (int i = 0; i < 8; ++i) {
            *(f32x4*)(xp + (i * 64 + lane) * 4) = v[i];
            ss += (v[i][0] * v[i][0] + v[i][1] * v[i][1]) + (v[i][2] * v[i][2] + v[i][3] * v[i][3]);
            if (!last) { u32x2 w; w.x = cvt_pk_bf16(v[i][0], v[i][1]); w.y = cvt_pk_bf16(v[i][2], v[i][3]);
                *(u32x2*)((bf16_t*)(P.ws + WS_XB) + (size_t)(MP + r) * 2048 + (i * 64 + lane) * 4) = w; }
        }
        const float t = ss + __shfl_xor(ss, 32);
        if (!last && lane < 32) ((float*)(P.ws + WS_SSP))[(size_t)(MP + r) * 32 + lane] = t;
    }
}

__device__ void prologue(LAS unsigned char* lds, const Params& P) {
    unsigned char* ws = P.ws;
    int job = 0; LAS unsigned* T = (LAS unsigned*)lds;
#pragma unroll 1
    for (int wi = 0; wi < 16; ++wi) {
        const float* src; bf16_t* dst; int K, N; const float* kg = nullptr; const float* ns = nullptr;
        if (wi == 0) { src = P.in[I_WINP]; dst = (bf16_t*)(ws + WS_WINP); K = 2048; N = 2048; kg = P.in[I_NMIX]; }
        else if (wi < 3) { const int l = wi - 1; src = P.in[I_WKV] + (size_t)l * 2048 * 1024; dst = (bf16_t*)(ws + WS_WKV) + (size_t)l * 1024 * 2048; K = 2048; N = 1024; kg = P.in[I_NMEM] + l * 2048; }
        else if (wi < 7) { const int gq = wi - 3; src = P.in[I_POOLW] + (size_t)gq * 384 * 384; dst = (bf16_t*)(ws + WS_POOLW) + (size_t)gq * 512 * 384; K = 384; N = 384; ns = P.in[I_PSCALE] + gq * 384; }
        else if (wi < 9) { const int l = wi - 7; src = P.in[I_WOUT] + (size_t)l * 2048 * 2048; dst = (bf16_t*)(ws + WS_WOUT) + (size_t)l * 2048 * 2048; K = 2048; N = 2048; }
        else if (wi < 11) { const int l = wi - 9; src = P.in[I_WUP] + (size_t)l * 2048 * 8192; dst = (bf16_t*)(ws + WS_WUP) + (size_t)l * 8192 * 2048; K = 2048; N = 8192; kg = P.in[I_NFFN] + l * 2048; }
        else if (wi < 13) { const int l = wi - 11; src = P.in[I_WDOWN] + (size_t)l * 8192 * 2048; dst = (bf16_t*)(ws + WS_WDOWN) + (size_t)l * 2048 * 8192; K = 8192; N = 2048; }
        else if (wi == 13) { src = P.in[I_WINS]; dst = (bf16_t*)(ws + WS_WINS); K = 2048; N = 5120; kg = P.in[I_NMIX] + 2048; }
        else continue;
        convT(T, src, dst, K, N, kg, ns, job);
    }
#pragma unroll 1
    for (int ri = 0; ri < 3; ++ri) {
        const float* src = ri == 0 ? P.in[I_XP] : (ri == 1 ? P.in[I_XS] : P.in[I_MEM]);
        const int nrows = ri == 0 ? MP : (ri == 1 ? MS : NMT);
        bf16_t* db = ri == 0 ? (bf16_t*)(ws + WS_XB) : (ri == 1 ? (bf16_t*)(ws + WS_XB) + (size_t)MP * 2048 : (bf16_t*)(ws + WS_MB));
        float* sp = ri == 0 ? (float*)(ws + WS_SSP) : (ri == 1 ? (float*)(ws + WS_SSP) + (size_t)MP * 32 : (float*)(ws + WS_SSPM));
        rows_to_bf16(src, nrows, db, sp);
    }
#pragma unroll 1
    for (int l = 0; l < 2; ++l) {
        const size_t n4 = (size_t)16 * 256 * 512 / 4;
        const int tid = otid();
        for (size_t i = (size_t)blockIdx.x * 512 + tid; i < 2 * n4; i += (size_t)gridDim.x * 512) {
            const bool isv = i >= n4; const size_t e = (isv ? i - n4 : i) * 4;
            const f32x4 v = *(const f32x4*)(P.in[isv ? I_CMV : I_CMK] + (size_t)l * 16 * 256 * 512 + e);
            u32x2 w; w.x = cvt_pk_bf16(v[0], v[1]); w.y = cvt_pk_bf16(v[2], v[3]);
            *(u32x2*)((bf16_t*)(ws + (isv ? WS_MV : WS_MK)) + ((size_t)l * 20 + 4) * 256 * 512 + e) = w;
        }
    }
}

DI int step_ngemm(int step) { return step == 1 ? 3 : ((step == 6 || step == 12) ? 2 : ((step == 0 || step == 2 || step == 7 || step == 9 || step == 13) ? 0 : 1)); }
DI GemmJob step_job(const Params& P, int step, int gi) {
    unsigned char* ws = P.ws; GemmJob g{};
    g.lda = 2048; g.ldb = 2048; g.K = 2048; g.nM = 66; g.nN = 8;
    const int layer = step >= 8 ? 1 : 0;
    if (step == 1) {
        if (gi == 0) { g.A = (const bf16_t*)(ws + WS_XB); g.Bt = (const bf16_t*)(ws + WS_WINP); g.mode = MODE_INPOOL; }
        else { const int l = gi - 1; g.A = (const bf16_t*)(ws + WS_MB); g.Bt = (const bf16_t*)(ws + WS_WKV) + (size_t)l * 1024 * 2048; g.nM = 4; g.nN = 4; g.mode = MODE_KV; g.layer = l; g.coff = 16 + 16 * l; }
    } else if (step == 3) { g.A = (const bf16_t*)(ws + WS_BIG + BG_D); g.Bt = (const bf16_t*)(ws + WS_POOLW); g.lda = 1536; g.ldb = 384; g.K = 384; g.mode = MODE_POOL; }
    else if (step == 4 || step == 10) { g.A = (const bf16_t*)(ws + WS_BIG + BG_CAT); g.Bt = (const bf16_t*)(ws + WS_WOUT) + (size_t)layer * 2048 * 2048; g.mode = MODE_RESID; g.layer = layer; }
    else if (step == 5 || step == 11) { g.A = (const bf16_t*)(ws + WS_XB); g.Bt = (const bf16_t*)(ws + WS_WUP) + (size_t)layer * 8192 * 2048; g.nN = 32; g.mode = MODE_UP; }
    else if (step == 6 || step == 12) { g.A = (const bf16_t*)(ws + WS_BIG); g.Bt = (const bf16_t*)(ws + WS_WDOWN) + (size_t)layer * 2048 * 8192; g.lda = 8192; g.ldb = 8192;
        if (gi == 0) { g.K = 8192; g.nM = 64; g.mode = MODE_RESID; g.layer = 1; g.last = layer; }
        else { g.K = 512; g.mode = MODE_PART; } }
    else { g.A = (const bf16_t*)(ws + WS_XB); g.Bt = (const bf16_t*)(ws + WS_WINS); g.nN = 20; g.mode = MODE_INSB; }
    return g;
}

__global__ void __launch_bounds__(512, 2) fwd_megakernel(Params P) {
    extern __shared__ __attribute__((aligned(16))) unsigned char smem[];
    LAS unsigned char* lds = (LAS unsigned char*)smem;
    cg::grid_group grid = cg::this_grid();
#pragma unroll 1
    for (int step = 0; step < 14; ++step) {
        if (step == 0) prologue(lds, P);
        if (step == 2) { pool_diff(P); memkv_finalize(P); }
        if (step == 7 || step == 13) down_fixup(P, step == 13);
        if (step == 9) sb_attn(lds, P);
        const int ng = step_ngemm(step);
#pragma unroll 1
        for (int gi = 0; gi < ng; ++gi) { const GemmJob g = step_job(P, step, gi); gemm_phase(lds, g, P); }
        if (step == 3 || step == 9) { __syncthreads(); mem_attn(lds, P, step == 9 ? 1 : 0); }
        if (step < 13) grid.sync();
    }
}

extern "C" void kernel_launch(void* const* d_in, const int* in_sizes, int n_in, void* d_out, int out_size, void* d_ws, size_t ws_size, hipStream_t stream) {
    static int state = 0;
    if (state == 0) {
        state = 1;
        if (n_in != 21 || ws_size < WS_END) { fprintf(stderr, "kernel_launch: need 21 inputs and %zu bytes of workspace (got %d, %zu)\n", (size_t)WS_END, n_in, ws_size); state = -1; }
        if (hipFuncSetAttribute((const void*)fwd_megakernel, hipFuncAttributeMaxDynamicSharedMemorySize, LDS_BYTES) != hipSuccess) { fprintf(stderr, "kernel_launch: hipFuncSetAttribute failed\n"); state = -1; }
        int per_cu = 0;
        if (hipOccupancyMaxActiveBlocksPerMultiprocessor(&per_cu, (const void*)fwd_megakernel, 512, LDS_BYTES) != hipSuccess || per_cu < 1) fprintf(stderr, "kernel_launch: occupancy query reports %d blocks per CU\n", per_cu);
        (void)hipGetLastError();
    }
    if (state < 0) return;
    Params p{};
    for (int i = 0; i < 21; ++i) p.in[i] = (const float*)d_in[i];
    p.out = (float*)d_out; p.ws = (unsigned char*)d_ws;
    void* args[] = {&p};
    hipError_t e = hipLaunchCooperativeKernel((const void*)fwd_megakernel, dim3(256), dim3(512), args, LDS_BYTES, stream);
    if (e != hipSuccess) fprintf(stderr, "cooperative launch failed: %s\n", hipGetErrorString(e));
}
```
